# Optimizing an MI355X kernel written in HIP

```python
import math
import jax, jax.numpy as jnp
from jax import lax
import numpy as np

D_MODEL = 1024
BATCH = 8
SEQ = 4096
DEPTH = 4

CHUNK = 64
N_HEADS_A = 8
HEAD_DIM_A = 64
V_DIM_A = 2 * HEAD_DIM_A
WIDTH_A = N_HEADS_A * V_DIM_A
N_QK = N_HEADS_A * 2 * HEAD_DIM_A
ROPE_THETA = 10000.0
Q_BLOCK = 128
N_GROUPS_B = 8
WIDTH_B = D_MODEL
GROUP_DIM_B = WIDTH_B // N_GROUPS_B
SGU_CHUNK = 128
D_FF = -(-8 * D_MODEL // (3 * 256)) * 256
NORM_EPS = 1e-6
N_IN = 2 * N_QK + WIDTH_A + 2 * WIDTH_B + 2 * D_MODEL
SPLITS = (N_QK, 2 * N_QK, 2 * N_QK + WIDTH_A, 2 * N_QK + WIDTH_A + WIDTH_B,
          2 * N_QK + WIDTH_A + 2 * WIDTH_B, 2 * N_QK + WIDTH_A + 2 * WIDTH_B + D_MODEL)

kernel_name = "hybrid_diffattn_gmlp_gated_block"


def rms_norm(x, g):
    xf = x.astype(jnp.float32)
    y = xf * lax.rsqrt(jnp.mean(xf * xf, axis=-1, keepdims=True) + NORM_EPS)
    return (y * g.astype(jnp.float32)).astype(x.dtype)


def layer_norm(x, g, b):
    xf = x.astype(jnp.float32)
    mu = jnp.mean(xf, axis=-1, keepdims=True)
    var = jnp.mean(jnp.square(xf - mu), axis=-1, keepdims=True)
    y = (xf - mu) * lax.rsqrt(var + NORM_EPS)
    return (y * g.astype(jnp.float32) + b.astype(jnp.float32)).astype(x.dtype)


def rotary(x, cos, sin):
    half = x.shape[-1] // 2
    x1, x2 = x[..., :half], x[..., half:]
    c = cos[None, :, None, None, :].astype(x.dtype)
    s = sin[None, :, None, None, :].astype(x.dtype)
    return jnp.concatenate([x1 * c - x2 * s, x2 * c + x1 * s], axis=-1)


def diff_attention(q, k, v, lam):
    B, S = q.shape[0], q.shape[1]
    nb = S // Q_BLOCK
    scale = HEAD_DIM_A ** -0.5
    qb = q.reshape(B, nb, Q_BLOCK, N_HEADS_A, 2, HEAD_DIM_A).transpose(1, 0, 3, 4, 2, 5)
    kt = k.transpose(0, 2, 3, 1, 4)
    vt = v.transpose(0, 2, 1, 3)
    k_chunk = jnp.arange(S) // CHUNK

    def block(args):
        q_blk, i = args
        s = jnp.einsum('bhmqd,bhmkd->bhmqk', q_blk, kt,
                       preferred_element_type=jnp.float32) * scale
        q_chunk = (i * Q_BLOCK + jnp.arange(Q_BLOCK)) // CHUNK
        allowed = k_chunk[None, :] <= q_chunk[:, None]
        s = jnp.where(allowed, s, jnp.float32(-1e30))
        p = jax.nn.softmax(s, axis=-1)
        a = p[:, :, 0] - lam * p[:, :, 1]
        return jnp.einsum('bhqk,bhke->bhqe', a.astype(vt.dtype), vt)

    o = lax.map(block, (qb, jnp.arange(nb)))
    return o.transpose(1, 0, 3, 2, 4).reshape(B, S, N_HEADS_A, V_DIM_A)


def spatial_gating(u, v, w_s, b_s, ln_g, ln_b):
    B, S = u.shape[0], u.shape[1]
    v = layer_norm(v, ln_g, ln_b)
    v = v.reshape(B, S // SGU_CHUNK, SGU_CHUNK, N_GROUPS_B, GROUP_DIM_B)
    pos_chunk = jnp.arange(SGU_CHUNK) // CHUNK
    mask = pos_chunk[None, :] <= pos_chunk[:, None]
    w = jnp.where(mask[None], w_s, jnp.zeros((), w_s.dtype))
    mixed = jnp.einsum('gts,bnsgc->bntgc', w, v) + b_s.T[:, :, None]
    return u * mixed.reshape(B, S, WIDTH_B)


def setup_inputs(seed: int = 0) -> dict:
    key = jax.random.key(seed)
    ks = jax.random.split(key, 24)
    f32 = jnp.float32

    def nrm(k, shape, scale):
        return jax.random.normal(k, shape, f32) * scale

    return {
        "x": nrm(ks[0], (BATCH, SEQ, D_MODEL), 1.0),
        "attn_norm_g": 1.0 + nrm(ks[1], (DEPTH, D_MODEL), 0.02),
        "w_in": nrm(ks[2], (DEPTH, D_MODEL, N_IN), D_MODEL ** -0.5),
        "lam_q1": nrm(ks[3], (DEPTH, HEAD_DIM_A), 0.1),
        "lam_k1": nrm(ks[4], (DEPTH, HEAD_DIM_A), 0.1),
        "lam_q2": nrm(ks[5], (DEPTH, HEAD_DIM_A), 0.1),
        "lam_k2": nrm(ks[6], (DEPTH, HEAD_DIM_A), 0.1),
        "subln_g": 1.0 + nrm(ks[7], (DEPTH, V_DIM_A), 0.02),
        "sgu_ln_g": 1.0 + nrm(ks[8], (DEPTH, WIDTH_B), 0.02),
        "sgu_ln_b": nrm(ks[9], (DEPTH, WIDTH_B), 0.02),
        "w_spatial": nrm(ks[10], (DEPTH, N_GROUPS_B, SGU_CHUNK, SGU_CHUNK), SGU_CHUNK ** -0.5),
        "b_spatial": 1.0 + nrm(ks[11], (DEPTH, N_GROUPS_B, SGU_CHUNK), 0.01),
        "w_proj_a": nrm(ks[12], (DEPTH, WIDTH_A, D_MODEL), WIDTH_A ** -0.5),
        "w_proj_b": nrm(ks[13], (DEPTH, WIDTH_B, D_MODEL), WIDTH_B ** -0.5),
        "w_out": nrm(ks[14], (DEPTH, D_MODEL, D_MODEL), D_MODEL ** -0.5),
        "ffn_norm_g": 1.0 + nrm(ks[15], (DEPTH, D_MODEL), 0.02),
        "w_gate": nrm(ks[16], (DEPTH, D_MODEL, D_FF), D_MODEL ** -0.5),
        "w_up": nrm(ks[17], (DEPTH, D_MODEL, D_FF), D_MODEL ** -0.5),
        "w_down": nrm(ks[18], (DEPTH, D_FF, D_MODEL), D_FF ** -0.5),
        "final_norm_g": 1.0 + nrm(ks[19], (D_MODEL,), 0.02),
    }


def reference(x, attn_norm_g, w_in, lam_q1, lam_k1, lam_q2, lam_k2, subln_g, sgu_ln_g, sgu_ln_b,
              w_spatial, b_spatial, w_proj_a, w_proj_b, w_out, ffn_norm_g, w_gate, w_up, w_down,
              final_norm_g):
    B, S = x.shape[0], x.shape[1]
    inv_freq = ROPE_THETA ** (-jnp.arange(0, HEAD_DIM_A, 2, dtype=jnp.float32) / HEAD_DIM_A)
    ang = jnp.arange(S, dtype=jnp.float32)[:, None] * inv_freq[None, :]
    cos, sin = jnp.cos(ang), jnp.sin(ang)

    for l in range(DEPTH):
        h = rms_norm(x, attn_norm_g[l])
        z = h @ w_in[l]
        q, k, v_a, u_b, v_b, g_a, g_b = jnp.split(z, SPLITS, axis=-1)

        lam_init = 0.8 - 0.6 * math.exp(-0.3 * l)
        lam = (jnp.exp(jnp.sum(lam_q1[l].astype(jnp.float32) * lam_k1[l].astype(jnp.float32)))
               - jnp.exp(jnp.sum(lam_q2[l].astype(jnp.float32) * lam_k2[l].astype(jnp.float32)))
               + lam_init)
        q = rotary(q.reshape(B, S, N_HEADS_A, 2, HEAD_DIM_A), cos, sin)
        k = rotary(k.reshape(B, S, N_HEADS_A, 2, HEAD_DIM_A), cos, sin)
        o_a = diff_attention(q, k, v_a.reshape(B, S, N_HEADS_A, V_DIM_A), lam)
        o_a = (rms_norm(o_a, subln_g[l]) * (1.0 - lam_init)).reshape(B, S, WIDTH_A)

        o_b = spatial_gating(jax.nn.gelu(u_b, approximate=False), jax.nn.gelu(v_b, approximate=False),
                             w_spatial[l], b_spatial[l], sgu_ln_g[l], sgu_ln_b[l])

        y = jax.nn.sigmoid(g_a) * (o_a @ w_proj_a[l]) + jax.nn.sigmoid(g_b) * (o_b @ w_proj_b[l])
        x = x + y @ w_out[l]

        h = rms_norm(x, ffn_norm_g[l])
        x = x + (jax.nn.silu(h @ w_gate[l]) * (h @ w_up[l])) @ w_down[l]

    return rms_norm(x, final_norm_g)
```

```cpp
#include <hip/hip_runtime.h>
#include <hip/hip_cooperative_groups.h>
#include <cstdio>
#include <cstdint>
namespace cg = cooperative_groups;
namespace pg8 {
#define PG8_LAS __attribute__((address_space(3)))
typedef unsigned short bf16_t;
typedef short bf16x8 __attribute__((ext_vector_type(8)));
typedef float f32x4 __attribute__((ext_vector_type(4)));
typedef unsigned u32x4 __attribute__((ext_vector_type(4)));
constexpr int BM = 256, BK = 64, HALF = 128, HTB = HALF * BK * 2  , STAGE_BYTES = 8 * HTB, NXCD = 8, WGM = 8;

__host__ __device__ __forceinline__ int lds_byte(int r, int c) { const int st = (r >> 4) * 2 + (c >> 5), rr = r & 15, cc = c & 31, ob = rr * 64 + cc * 2; return st * 1024 + (ob ^ (((ob >> 9) & 1) << 5)); }
__host__ __device__ __forceinline__ void stage_rc(int b, int& R, int& C) { const int st = b / 1024, sb = b % 1024, swz = sb ^ (((sb >> 9) & 1) << 5); R = (st >> 1) * 16 + swz / 64; C = (st & 1) * 32 + (swz % 64) / 2; }
__host__ __device__ __forceinline__ int perm32(int rho) { const int n = rho >> 4, i = rho & 15; return 8 * (i >> 2) + 4 * n + (i & 3); }

struct Unit { int pm, pn, ord; };
struct Gemm { const bf16_t* A; const bf16_t* Bt; int M, N, K; };

struct StaticOrder {
    int nM, nN, nwg, G, c;
    __host__ __device__ void init(int M, int N, int G_, int c_) { nM = M / BM; nN = N / BM; nwg = nM * nN; G = G_; c = c_; }
    __host__ __device__ bool next(int i, Unit& u) const {
        const long L = (long)i * G + c; if (L >= nwg) return false;
        int wgid = (int)L; { const int q = nwg / NXCD, r = nwg % NXCD, xcd = wgid % NXCD, off = wgid / NXCD; wgid = (xcd < r ? xcd * (q + 1) : r * (q + 1) + (xcd - r) * q) + off; }
        const int nig = WGM * nN, gid = wgid / nig, fm = gid * WGM, gsz = (nM - fm) < WGM ? (nM - fm) : WGM;
        u.pm = fm + ((wgid % nig) % gsz); u.pn = (wgid % nig) / gsz; u.ord = i; return true;
    }
    __device__ __forceinline__ void a_ready(const Unit&) const {}
    __device__ __forceinline__ void done(const Unit&) const {}
};

__device__ __forceinline__ unsigned cvt_pk_bf16(float lo, float hi) { unsigned r; asm volatile("v_cvt_pk_bf16_f32 %0, %1, %2" : "=v"(r) : "v"(lo), "v"(hi)); return r; }
typedef float f32x2 __attribute__((ext_vector_type(2)));
__device__ __forceinline__ f32x2 gelu_pk(f32x2 v) {
    const f32x2 av = __builtin_elementwise_abs(v), d = av * 0.2316418882f + 1.0f;
    f32x2 t; t.x = __builtin_amdgcn_rcpf(d.x); t.y = __builtin_amdgcn_rcpf(d.y);
    f32x2 q = t * 0.5307027145f + (-0.7265760135f); q = q * t + 0.7107068705f; q = q * t + (-0.142248368f); q = q * t + 0.127414796f; q = q * t;
    const f32x2 s = (v * v) * (-0.72134752044f);
    f32x2 e; e.x = __builtin_amdgcn_exp2f(s.x); e.y = __builtin_amdgcn_exp2f(s.y);
    const f32x2 m = v * (q * e), r = v - m;
    f32x2 o; o.x = v.x < 0.f ? m.x : r.x; o.y = v.y < 0.f ? m.y : r.y; return o;
}
typedef unsigned u32x2 __attribute__((ext_vector_type(2)));
__device__ __forceinline__ float sigmoid_f(float x) { return __builtin_amdgcn_rcpf(1.f + __builtin_amdgcn_exp2f(-1.4426950408889634f * x)); }
__device__ __forceinline__ float bf_lo(unsigned w) { return __uint_as_float(w << 16); }
__device__ __forceinline__ float bf_hi(unsigned w) { return __uint_as_float(w & 0xffff0000u); }
__device__ __forceinline__ float row_rstd(const float* SS, int row, int fq) {
    const f32x4 p = *(const f32x4*)(SS + (size_t)row * 16 + 4 * fq);
    float s = (p[0] + p[1]) + (p[2] + p[3]);
    s += __shfl_xor(s, 16); s += __shfl_xor(s, 32);
    return rsqrtf(s * (1.0f / 1024.0f) + 1e-6f);
}
__device__ __forceinline__ u32x4 pack8(const f32x4 a, const f32x4 b) { u32x4 w; w.x = cvt_pk_bf16(a[0], a[1]); w.y = cvt_pk_bf16(a[2], a[3]); w.z = cvt_pk_bf16(b[0], b[1]); w.w = cvt_pk_bf16(b[2], b[3]); return w; }
__device__ __forceinline__ f32x4 gelu4(const f32x4 v) { const f32x2 a = gelu_pk((f32x2){v[0], v[1]}), b = gelu_pk((f32x2){v[2], v[3]}); return (f32x4){a.x, a.y, b.x, b.y}; }
__device__ __forceinline__ float row_rstd(const float* SS, int row, int fq);
__device__ __forceinline__ float rstd_lds(const PG8_LAS float* tab, int nu, const float* SS, const Unit& u, int lrow, int row, int fq) { return u.ord < nu ? tab[u.ord * 256 + lrow] : row_rstd(SS, row, fq); }
constexpr float QSCALE = 0.125f * 1.4426950408889634f;

struct EpiIn {
    static constexpr bool PERM = true, AFTER_DRAIN = false;
    const float* SS; const float* cosT; const float* sinT;
    bf16_t *Q, *K, *VA, *U, *VB; unsigned char *GA8, *GB8; float* VST; const PG8_LAS float* rtab; int rnu;
    __device__ __forceinline__ void operator()(const f32x4 (&acc)[2][2][4][2], const Unit& u, int wr, int wc, int fr, int fq) const {
        const int row0 = u.pm * BM + wr * 64 + fr;
        const int sec = u.pn >> 2, pnl = u.pn & 3;
        const int col0 = pnl * BM + wc * 32 + 8 * fq;
        if (sec <= 1) {
            bf16_t* O = sec == 0 ? Q : K; const float sc = sec == 0 ? QSCALE : 1.0f;
            const int j0 = 4 * ((4 * wc + fq) & 7);
#pragma unroll
            for (int ai = 0; ai < 2; ++ai)
#pragma unroll
                for (int m = 0; m < 4; ++m) { const int row = row0 + ai * HALF + m * 16; const float rs = rstd_lds(rtab, rnu, SS, u, wr * 64 + fr + ai * HALF + m * 16, row, fq) * sc;
                    const int pos = row & 4095; const f32x4 c4 = *(const f32x4*)(cosT + pos * 32 + j0), s4 = *(const f32x4*)(sinT + pos * 32 + j0);
#pragma unroll
                    for (int bj = 0; bj < 2; ++bj) { const f32x4 x1 = acc[ai][bj][m][0] * rs, x2 = acc[ai][bj][m][1] * rs;
                        const f32x4 o1 = x1 * c4 - x2 * s4, o2 = x2 * c4 + x1 * s4;
                        *(u32x4*)(O + (size_t)row * 1024 + col0 + bj * HALF) = pack8(o1, o2); } }
        } else if (sec == 2) {
#pragma unroll
            for (int ai = 0; ai < 2; ++ai)
#pragma unroll
                for (int m = 0; m < 4; ++m) { const int row = row0 + ai * HALF + m * 16; const float rs = rstd_lds(rtab, rnu, SS, u, wr * 64 + fr + ai * HALF + m * 16, row, fq);
#pragma unroll
                    for (int bj = 0; bj < 2; ++bj) *(u32x4*)(VA + (size_t)row * 1024 + col0 + bj * HALF) = pack8(acc[ai][bj][m][0] * rs, acc[ai][bj][m][1] * rs); }
        } else if (sec == 3) {
#pragma unroll
            for (int ai = 0; ai < 2; ++ai)
#pragma unroll
                for (int m = 0; m < 4; ++m) { const int row = row0 + ai * HALF + m * 16; const float rs = rstd_lds(rtab, rnu, SS, u, wr * 64 + fr + ai * HALF + m * 16, row, fq);
#pragma unroll
                    for (int bj = 0; bj < 2; ++bj) *(u32x4*)(U + (size_t)row * 1024 + col0 + bj * HALF) = pack8(gelu4(acc[ai][bj][m][0] * rs), gelu4(acc[ai][bj][m][1] * rs)); }
        } else if (sec == 4) {
#pragma unroll
            for (int ai = 0; ai < 2; ++ai)
#pragma unroll
                for (int m = 0; m < 4; ++m) { const int row = row0 + ai * HALF + m * 16; const float rs = rstd_lds(rtab, rnu, SS, u, wr * 64 + fr + ai * HALF + m * 16, row, fq); float s1 = 0.f, s2 = 0.f;
#pragma unroll
                    for (int bj = 0; bj < 2; ++bj) { const f32x4 a = gelu4(acc[ai][bj][m][0] * rs), b = gelu4(acc[ai][bj][m][1] * rs);
                        s1 += ((a[0] + a[1]) + (a[2] + a[3])) + ((b[0] + b[1]) + (b[2] + b[3]));
                        s2 += ((a[0] * a[0] + a[1] * a[1]) + (a[2] * a[2] + a[3] * a[3])) + ((b[0] * b[0] + b[1] * b[1]) + (b[2] * b[2] + b[3] * b[3]));
                        *(u32x4*)(VB + (size_t)row * 1024 + col0 + bj * HALF) = pack8(a, b); }
                    s1 += __shfl_xor(s1, 16); s1 += __shfl_xor(s1, 32); s2 += __shfl_xor(s2, 16); s2 += __shfl_xor(s2, 32);
                    if (fq == 0) *(f32x2*)(VST + ((size_t)row * 16 + 4 * pnl + wc) * 2) = (f32x2){s1, s2}; }
        } else {
            unsigned char* G = sec == 5 ? GA8 : GB8;
#pragma unroll
            for (int ai = 0; ai < 2; ++ai)
#pragma unroll
                for (int m = 0; m < 4; ++m) { const int row = row0 + ai * HALF + m * 16; const float rs = rstd_lds(rtab, rnu, SS, u, wr * 64 + fr + ai * HALF + m * 16, row, fq);
#pragma unroll
                    for (int bj = 0; bj < 2; ++bj) { const f32x4 a = acc[ai][bj][m][0] * rs, b = acc[ai][bj][m][1] * rs; unsigned q[8];
#pragma unroll
                        for (int e = 0; e < 4; ++e) { q[e] = (unsigned)(sigmoid_f(a[e]) * 255.0f + 0.5f); q[4 + e] = (unsigned)(sigmoid_f(b[e]) * 255.0f + 0.5f); }
                        u32x2 w; w.x = q[0] | (q[1] << 8) | (q[2] << 16) | (q[3] << 24); w.y = q[4] | (q[5] << 8) | (q[6] << 16) | (q[7] << 24);
                        *(u32x2*)(G + (size_t)row * 1024 + col0 + bj * HALF) = w; } }
        }
    }
};
struct EpiProj {
    static constexpr bool PERM = true, AFTER_DRAIN = false;
    const unsigned char *GA8, *GB8; bf16_t* Y;
    __device__ __forceinline__ void operator()(const f32x4 (&acc)[2][2][4][2], const Unit& u, int wr, int wc, int fr, int fq) const {
        const int s = u.pm >> 7; const int row0 = (u.pm & 127) * BM + wr * 64 + fr; const int col0 = (u.pn & 3) * BM + wc * 32 + 8 * fq;
        const unsigned char* G = s ? GB8 : GA8; const float k = 1.0f / 255.0f;
#pragma unroll
        for (int ai = 0; ai < 2; ++ai)
#pragma unroll
            for (int m = 0; m < 4; ++m)
#pragma unroll
                for (int bj = 0; bj < 2; ++bj) { const size_t off = (size_t)(row0 + ai * HALF + m * 16) * 1024 + col0 + bj * HALF;
                    const u32x2 g = *(const u32x2*)(G + off);
                    f32x4 ga = (f32x4){(float)(g.x & 255u), (float)((g.x >> 8) & 255u), (float)((g.x >> 16) & 255u), (float)(g.x >> 24)} * k;
                    f32x4 gb = (f32x4){(float)(g.y & 255u), (float)((g.y >> 8) & 255u), (float)((g.y >> 16) & 255u), (float)(g.y >> 24)} * k;
                    f32x4 v0 = acc[ai][bj][m][0] * ga, v1 = acc[ai][bj][m][1] * gb;
                    if (s) { const u32x4 y = *(const u32x4*)(Y + off);
                        v0 += (f32x4){bf_lo(y.x), bf_hi(y.x), bf_lo(y.y), bf_hi(y.y)}; v1 += (f32x4){bf_lo(y.z), bf_hi(y.z), bf_lo(y.w), bf_hi(y.w)}; }
                    *(u32x4*)(Y + off) = pack8(v0, v1); }
    }
};
struct EpiRes {
    static constexpr bool PERM = true, AFTER_DRAIN = false;
    bf16_t* XB; float* SS;
    __device__ __forceinline__ void operator()(const f32x4 (&acc)[2][2][4][2], const Unit& u, int wr, int wc, int fr, int fq) const {
        const int row0 = u.pm * BM + wr * 64 + fr; const int col0 = u.pn * BM + wc * 32 + 8 * fq;
#pragma unroll
        for (int ai = 0; ai < 2; ++ai)
#pragma unroll
            for (int m = 0; m < 4; ++m) { const int row = row0 + ai * HALF + m * 16; float q = 0.f;
#pragma unroll
                for (int bj = 0; bj < 2; ++bj) { const size_t off = (size_t)row * 1024 + col0 + bj * HALF;
                    const u32x4 xo = *(const u32x4*)(XB + off);
                    const f32x4 v0 = acc[ai][bj][m][0] + (f32x4){bf_lo(xo.x), bf_hi(xo.x), bf_lo(xo.y), bf_hi(xo.y)}, v1 = acc[ai][bj][m][1] + (f32x4){bf_lo(xo.z), bf_hi(xo.z), bf_lo(xo.w), bf_hi(xo.w)};
                    *(u32x4*)(XB + off) = pack8(v0, v1);
                    q += ((v0[0] * v0[0] + v0[1] * v0[1]) + (v0[2] * v0[2] + v0[3] * v0[3])) + ((v1[0] * v1[0] + v1[1] * v1[1]) + (v1[2] * v1[2] + v1[3] * v1[3])); }
                q += __shfl_xor(q, 16); q += __shfl_xor(q, 32);
                if (fq == 0) SS[(size_t)row * 16 + 4 * u.pn + wc] = q; }
    }
};
struct EpiGU {
    static constexpr bool PERM = true, AFTER_DRAIN = false;
    const float* SS; bf16_t* H; const PG8_LAS float* rtab; int rnu;
    __device__ __forceinline__ void operator()(const f32x4 (&acc)[2][2][4][2], const Unit& u, int wr, int wc, int fr, int fq) const {
        const int row0 = u.pm * BM + wr * 64 + fr; const int hc0 = u.pn * 128 + wc * 16 + 4 * fq;
#pragma unroll
        for (int ai = 0; ai < 2; ++ai)
#pragma unroll
            for (int m = 0; m < 4; ++m) { const int row = row0 + ai * HALF + m * 16; const float rs = rstd_lds(rtab, rnu, SS, u, wr * 64 + fr + ai * HALF + m * 16, row, fq);
#pragma unroll
                for (int bj = 0; bj < 2; ++bj) { const f32x4 g = acc[ai][bj][m][0] * rs, up = acc[ai][bj][m][1] * rs; f32x4 h;
#pragma unroll
                    for (int e = 0; e < 4; ++e) h[e] = g[e] * sigmoid_f(g[e]) * up[e];
                    u32x2 w; w.x = cvt_pk_bf16(h[0], h[1]); w.y = cvt_pk_bf16(h[2], h[3]);
                    *(u32x2*)(H + (size_t)row * 2816 + hc0 + bj * 64) = w; } }
    }
};
struct ProjOrder {
    StaticOrder b;
    __host__ __device__ void init(int M, int N, int G_, int c_) { b.init(M, N, G_, c_); }
    __host__ __device__ bool next(int i, Unit& u) const { Unit t; if (!b.next(i >> 1, t)) return false; u.pm = t.pm + 128 * (i & 1); u.pn = t.pn + 4 * (i & 1); return true; }
    __device__ __forceinline__ void a_ready(const Unit&) const {}
    __device__ __forceinline__ void done(const Unit&) const {}
};
template <class Epi, class Sched, bool ALIGN_EPI = false, bool SP2 = false>
__device__ __forceinline__ void gemm_phase(PG8_LAS unsigned char* lds, const Gemm g, const Sched& S, const Epi& E) {
    int tid_ = threadIdx.x; asm volatile("" : "+v"(tid_));
    const int tid = tid_, wid = __builtin_amdgcn_readfirstlane(tid >> 6), lane = tid & 63, wr = wid >> 2, wc = wid & 3, fr = lane & 15, fq = lane >> 4;
    const int K = g.K, nt = K / BK;
    unsigned voffA[2], voffB[2];
#pragma unroll
    for (int i = 0; i < 2; ++i) { int R, C; stage_rc(tid * 16 + i * 8192, R, C); const int Rb = Epi::PERM ? ((R & ~31) + perm32(R & 31)) : R;
        voffA[i] = (unsigned)(R * K + C) * 2u; voffB[i] = (unsigned)(Rb * K + C) * 2u; }
    const size_t kstep = (size_t)(BK * 2);
    const size_t hstep = (size_t)HALF * K * 2;
    const size_t tstep = 2 * hstep;
    const unsigned ldsw = (unsigned)wid * 1024u;
    const int aoff = lds_byte(wr * 64 + fr, fq * 8), boff = lds_byte(wc * 32 + fr, fq * 8);
#define PG8_SA(b, h) (((b) * 2 + (h)) * HTB)
#define PG8_SB(b, h) ((4 + (b) * 2 + (h)) * HTB)
#define PG8_STAGE(bufoff, gbase, voff) do { _Pragma("unroll") for (int _i = 0; _i < 2; ++_i) \
        __builtin_amdgcn_global_load_lds((const unsigned*)((const char*)(gbase) + (voff)[_i]), (PG8_LAS unsigned*)(lds + (bufoff) + ldsw + _i * 8192), 16, 0, 0); } while (0)
#define PG8_LDA(dst, b, h) do { _Pragma("unroll") for (int m = 0; m < 4; ++m) _Pragma("unroll") for (int k = 0; k < 2; ++k) dst[m][k] = *(const PG8_LAS bf16x8*)(lds + PG8_SA(b, h) + aoff + m * 2048 + k * 1024); } while (0)
#define PG8_LDB(dst, b, h) do { _Pragma("unroll") for (int n = 0; n < 2; ++n) _Pragma("unroll") for (int k = 0; k < 2; ++k) dst[n][k] = *(const PG8_LAS bf16x8*)(lds + PG8_SB(b, h) + boff + n * 2048 + k * 1024); } while (0)
#define PG8_MMA(ai, bj, At, Bt) do { __builtin_amdgcn_s_setprio(1); _Pragma("unroll") for (int m = 0; m < 4; ++m) _Pragma("unroll") for (int n = 0; n < 2; ++n) _Pragma("unroll") for (int k = 0; k < 2; ++k) \
        acc[ai][bj][m][n] = __builtin_amdgcn_mfma_f32_16x16x32_bf16(Bt[n][k], At[m][k], acc[ai][bj][m][n], 0, 0, 0); __builtin_amdgcn_s_setprio(0); } while (0)
#define PG8_WAIT_V(n) asm volatile("s_waitcnt vmcnt(" #n ")" ::: "memory")
#define PG8_WAIT_L(n) asm volatile("s_waitcnt lgkmcnt(" #n ")" ::: "memory")
#define PG8_BAR __builtin_amdgcn_s_barrier()
#define PG8_SCHED __builtin_amdgcn_sched_barrier(0)
    Unit cur, nxt; int ui = 0;
    if (!S.next(0, cur)) return;
    f32x4 acc[2][2][4][2];
#pragma unroll
    for (int a = 0; a < 2; ++a)
#pragma unroll
        for (int b = 0; b < 2; ++b)
#pragma unroll
            for (int m = 0; m < 4; ++m)
#pragma unroll
                for (int n = 0; n < 2; ++n) acc[a][b][m][n] = (f32x4){0.f, 0.f, 0.f, 0.f};
    bf16x8 At[4][2], B0[2][2], B1[2][2];
    const char* cA = (const char*)g.A + (size_t)cur.pm * tstep; const char* cB = (const char*)g.Bt + (size_t)cur.pn * tstep;
    S.a_ready(cur);
    if constexpr (SP2) {
        PG8_STAGE(PG8_SB(0, 0), cB, voffB); PG8_STAGE(PG8_SB(0, 1), cB + hstep, voffB); PG8_STAGE(PG8_SA(0, 0), cA, voffA); PG8_STAGE(PG8_SA(0, 1), cA + hstep, voffA);
        if (wr == 1) PG8_BAR;
        PG8_WAIT_V(2); PG8_BAR;
        PG8_STAGE(PG8_SB(1, 0), cB + kstep, voffB); PG8_STAGE(PG8_SA(1, 0), cA + kstep, voffA); PG8_STAGE(PG8_SB(1, 1), cB + hstep + kstep, voffB);
        PG8_WAIT_V(6); PG8_BAR;
    } else {
        PG8_STAGE(PG8_SB(0, 0), cB, voffB); PG8_STAGE(PG8_SA(0, 0), cA, voffA); PG8_STAGE(PG8_SB(0, 1), cB + hstep, voffB); PG8_STAGE(PG8_SA(0, 1), cA + hstep, voffA);
        if (wr == 1) PG8_BAR;
        PG8_WAIT_V(4); PG8_BAR;
        PG8_STAGE(PG8_SB(1, 0), cB + kstep, voffB); PG8_STAGE(PG8_SA(1, 0), cA + kstep, voffA); PG8_STAGE(PG8_SB(1, 1), cB + hstep + kstep, voffB);
        PG8_WAIT_V(6); PG8_BAR;
    }
    for (;;) {
        const bool has_next = S.next(ui + 1, nxt);
        const char* nA = has_next ? (const char*)g.A + (size_t)nxt.pm * tstep : cA; const char* nB = has_next ? (const char*)g.Bt + (size_t)nxt.pn * tstep : cB;
        for (int t = 0; t < nt; t += 2) {
            const bool last = (t == nt - 2);
            const char* a1 = cA + (size_t)(t + 1) * kstep;
            const char* a2 = last ? nA : cA + (size_t)(t + 2) * kstep; const char* b2 = last ? nB : cB + (size_t)(t + 2) * kstep;
            const char* a3 = a2 + kstep; const char* b3 = b2 + kstep;
            if (last && has_next) S.a_ready(nxt);
            if constexpr (SP2) {
            PG8_LDB(B0, 0, 0); PG8_LDB(B1, 0, 1); PG8_SCHED; PG8_LDA(At, 0, 0); PG8_STAGE(PG8_SA(1, 1), a1 + hstep, voffA);
            PG8_WAIT_V(8); PG8_WAIT_L(0); PG8_BAR; PG8_MMA(0, 0, At, B0); PG8_MMA(0, 1, At, B1); PG8_BAR; PG8_SCHED;
            PG8_LDA(At, 0, 1); PG8_STAGE(PG8_SB(0, 0), b2, voffB); PG8_STAGE(PG8_SB(0, 1), b2 + hstep, voffB); PG8_STAGE(PG8_SA(0, 0), a2, voffA);
            PG8_WAIT_V(8); PG8_WAIT_L(0); PG8_BAR; PG8_MMA(1, 0, At, B0); PG8_MMA(1, 1, At, B1); PG8_BAR; PG8_SCHED;
            PG8_LDB(B0, 1, 0); PG8_LDB(B1, 1, 1); PG8_SCHED; PG8_LDA(At, 1, 0); PG8_STAGE(PG8_SA(0, 1), a2 + hstep, voffA);
            PG8_WAIT_V(8); PG8_WAIT_L(0); PG8_BAR; PG8_MMA(0, 0, At, B0); PG8_MMA(0, 1, At, B1); PG8_BAR; PG8_SCHED;
            PG8_LDA(At, 1, 1); PG8_STAGE(PG8_SB(1, 0), b3, voffB); PG8_STAGE(PG8_SB(1, 1), b3 + hstep, voffB); PG8_STAGE(PG8_SA(1, 0), a3, voffA);
            PG8_WAIT_V(8); PG8_WAIT_L(0); PG8_BAR; PG8_MMA(1, 0, At, B0); PG8_MMA(1, 1, At, B1); PG8_BAR; PG8_SCHED;
            } else {
            PG8_LDB(B0, 0, 0); PG8_SCHED; PG8_LDA(At, 0, 0); PG8_STAGE(PG8_SA(1, 1), a1 + hstep, voffA);
            PG8_WAIT_L(8); PG8_BAR; PG8_WAIT_L(0); PG8_MMA(0, 0, At, B0); PG8_BAR; PG8_SCHED;
            PG8_LDB(B1, 0, 1); PG8_STAGE(PG8_SB(0, 0), b2, voffB);
            PG8_BAR; PG8_WAIT_L(0); PG8_MMA(0, 1, At, B1); PG8_BAR;
            PG8_LDA(At, 0, 1); PG8_STAGE(PG8_SA(0, 0), a2, voffA);
            PG8_BAR; PG8_WAIT_L(0); PG8_MMA(1, 0, At, B0); PG8_BAR; PG8_SCHED;
            PG8_STAGE(PG8_SB(0, 1), b2 + hstep, voffB);
            PG8_WAIT_V(6); PG8_BAR; PG8_MMA(1, 1, At, B1); PG8_BAR;
            PG8_LDB(B0, 1, 0); PG8_SCHED; PG8_LDA(At, 1, 0); PG8_STAGE(PG8_SA(0, 1), a2 + hstep, voffA);
            PG8_WAIT_L(8); PG8_BAR; PG8_WAIT_L(0); PG8_MMA(0, 0, At, B0); PG8_BAR; PG8_SCHED;
            PG8_LDB(B1, 1, 1); PG8_STAGE(PG8_SB(1, 0), b3, voffB);
            PG8_BAR; PG8_WAIT_L(0); PG8_MMA(0, 1, At, B1); PG8_BAR;
            PG8_LDA(At, 1, 1); PG8_STAGE(PG8_SA(1, 0), a3, voffA);
            PG8_BAR; PG8_WAIT_L(0); PG8_MMA(1, 0, At, B0); PG8_BAR; PG8_SCHED;
            PG8_STAGE(PG8_SB(1, 1), b3 + hstep, voffB);
            PG8_WAIT_V(6); PG8_BAR; PG8_MMA(1, 1, At, B1); PG8_BAR;
            }
        }
        if constexpr (ALIGN_EPI) { if (wr == 0) PG8_BAR; }
        if constexpr (!Epi::AFTER_DRAIN) { E(acc, cur, wr, wc, fr, fq); S.done(cur); }
        if (!has_next) break;
#pragma unroll
        for (int a = 0; a < 2; ++a)
#pragma unroll
            for (int b = 0; b < 2; ++b)
#pragma unroll
                for (int m = 0; m < 4; ++m)
#pragma unroll
                    for (int n = 0; n < 2; ++n) acc[a][b][m][n] = (f32x4){0.f, 0.f, 0.f, 0.f};
        cur = nxt; cA = nA; cB = nB; ++ui;
        if constexpr (ALIGN_EPI) { if (wr == 1) PG8_BAR; }
    }
    PG8_WAIT_V(0);
    if constexpr (!ALIGN_EPI) { if (wr == 0) PG8_BAR; }
    PG8_BAR;
    if constexpr (Epi::AFTER_DRAIN) { E.fused(acc, cur, wr, wc, fr, fq, lds, wid, lane); S.done(cur); }
#undef PG8_SA
#undef PG8_SB
#undef PG8_STAGE
#undef PG8_LDA
#undef PG8_LDB
#undef PG8_MMA
#undef PG8_WAIT_V
#undef PG8_WAIT_L
#undef PG8_BAR
#undef PG8_SCHED
}
}

constexpr int BATCH = 8, SEQ = 4096, DM = 1024, DEPTH = 4, T = BATCH * SEQ, NIN = 7168, DFF = 2816, NGU = 2 * DFF;
constexpr int NWAVES = 8, NTHR = 512;
#define LAS __attribute__((address_space(3)))
typedef unsigned short bf16;
typedef short bf16x8 __attribute__((ext_vector_type(8)));
typedef short s16x4 __attribute__((ext_vector_type(4)));
typedef float f32x4 __attribute__((ext_vector_type(4)));
typedef float f32x2 __attribute__((ext_vector_type(2)));
typedef float f32x16 __attribute__((ext_vector_type(16)));
typedef unsigned u32x4 __attribute__((ext_vector_type(4)));
typedef unsigned u32x2 __attribute__((ext_vector_type(2)));
constexpr size_t MiB = 1u << 20;
constexpr size_t WS_COS = 1 * MiB, WS_SIN = WS_COS + MiB / 2, WS_WSP = 2 * MiB, WS_SS = 3 * MiB, WS_VST = 5 * MiB;
constexpr size_t WS_WIN = 10 * MiB, WS_WPAB = 24 * MiB, WS_WOUT = 28 * MiB, WS_WGU = 30 * MiB, WS_WD = 41 * MiB;
constexpr size_t WS_XB = 48 * MiB, WS_Q = 112 * MiB, WS_U = 176 * MiB, WS_K = 240 * MiB, WS_VA = 304 * MiB, WS_VB = 368 * MiB, WS_GA = 432 * MiB, WS_GB = 464 * MiB, WS_END = 496 * MiB;
constexpr size_t WS_Y = WS_K, WS_H = WS_K;
static_assert(WS_U == WS_Q + (size_t)T * DM * 2 && WS_H + (size_t)T * DFF * 2 <= WS_GA, "ws map");
constexpr int LDS_BYTES = 147456, LDS_XB = 147456 - 64;
constexpr size_t WS_CTL = 0, CTL_ZERO_BYTES = 16384;

__device__ __forceinline__ unsigned f2bf(float f) { unsigned u = __builtin_bit_cast(unsigned, f); return (u + 0x7fffu + ((u >> 16) & 1u)) >> 16; }
__device__ __forceinline__ unsigned pk2(float lo, float hi) { return f2bf(lo) | (f2bf(hi) << 16); }
__device__ __forceinline__ float bflo(unsigned w) { return __uint_as_float(w << 16); }
__device__ __forceinline__ float bfhi(unsigned w) { return __uint_as_float(w & 0xffff0000u); }
__device__ __forceinline__ float wave_sum(float v) {
#pragma unroll
    for (int o = 1; o < 64; o <<= 1) v += __shfl_xor(v, o);
    return v;
}
struct Params {
    const float* in[20]; float* out; unsigned char* ws; int ph_lo, ph_hi;
};
typedef const __attribute__((address_space(4))) Params* PP;
struct MapId { __device__ __forceinline__ int operator()(int n) const { return n; } };
struct MapIn {
    __device__ __forceinline__ int operator()(int n) const { if (n >= 2048) return n; const int j = n & 63, jj = j & 31; return (n & ~63) + 8 * (jj >> 2) + (jj & 3) + ((j >> 5) << 2); } };
struct MapGU { int up;
    __device__ __forceinline__ int operator()(int hd) const { const int r = hd & 127; return 256 * (hd >> 7) + 8 * (r >> 2) + 4 * up + (r & 3); } };
template <class Map>
__device__ __forceinline__ void transpose_item(const float* W, int K, int N, bf16* WT, const float* gk, const Map& mp, LAS float* scr, int item, int lane) {
    const int nblk = N / 32, kb = item / nblk, nb = item % nblk, k0 = 64 * kb, n0 = 32 * nb;
#pragma unroll 8
    for (int i = 0; i < 32; ++i) { const int kk = 2 * i + (lane >> 5); scr[kk * 33 + (lane & 31)] = W[(size_t)(k0 + kk) * N + n0 + (lane & 31)]; }
    asm volatile("s_waitcnt lgkmcnt(0)" ::: "memory");
    const int c = lane & 7; float gs[8];
#pragma unroll
    for (int e = 0; e < 8; ++e) gs[e] = gk ? gk[k0 + 8 * c + e] : 1.0f;
#pragma unroll
    for (int j = 0; j < 4; ++j) { const int n = (lane >> 3) + 8 * j; const LAS float* s = scr + (8 * c) * 33 + n;
        u32x4 o; o.x = pk2(s[0 * 33] * gs[0], s[1 * 33] * gs[1]); o.y = pk2(s[2 * 33] * gs[2], s[3 * 33] * gs[3]); o.z = pk2(s[4 * 33] * gs[4], s[5 * 33] * gs[5]); o.w = pk2(s[6 * 33] * gs[6], s[7 * 33] * gs[7]);
        *(u32x4*)(WT + (size_t)mp(n0 + n) * K + k0 + 8 * c) = o; }
    asm volatile("s_waitcnt lgkmcnt(0)" ::: "memory");
}
struct CvItem { const float* W; bf16* WT; const float* gk; int K, N, mk, item; };
__device__ __forceinline__ int cv_map(int mk, int n) { return mk == 0 ? n : mk == 1 ? MapIn{}(n) : MapGU{mk - 2}(n); }
__device__ __forceinline__ void cv_load(const CvItem& d, int lane, float (&wv)[32]) {
    const int nblk = d.N / 32, kb = d.item / nblk, nb = d.item % nblk, k0 = 64 * kb, n0 = 32 * nb;
#pragma unroll
    for (int i = 0; i < 32; ++i) wv[i] = d.W[(size_t)(k0 + 2 * i + (lane >> 5)) * d.N + n0 + (lane & 31)];
}
__device__ __forceinline__ void cv_store(const CvItem& d, LAS float* scr, int lane, const float (&wv)[32]) {
    const int nblk = d.N / 32, kb = d.item / nblk, nb = d.item % nblk, k0 = 64 * kb, n0 = 32 * nb;
#pragma unroll
    for (int i = 0; i < 32; ++i) scr[(2 * i + (lane >> 5)) * 33 + (lane & 31)] = wv[i];
    asm volatile("s_waitcnt lgkmcnt(0)" ::: "memory");
    const int c = lane & 7; float gs[8];
#pragma unroll
    for (int e = 0; e < 8; ++e) gs[e] = d.gk ? d.gk[k0 + 8 * c + e] : 1.0f;
#pragma unroll
    for (int j = 0; j < 4; ++j) { const int n = (lane >> 3) + 8 * j; const LAS float* s = scr + (8 * c) * 33 + n;
        u32x4 o; o.x = pk2(s[0 * 33] * gs[0], s[1 * 33] * gs[1]); o.y = pk2(s[2 * 33] * gs[2], s[3 * 33] * gs[3]); o.z = pk2(s[4 * 33] * gs[4], s[5 * 33] * gs[5]); o.w = pk2(s[6 * 33] * gs[6], s[7 * 33] * gs[7]);
        *(u32x4*)(d.WT + (size_t)cv_map(d.mk, n0 + n) * d.K + k0 + 8 * c) = o; }
    asm volatile("s_waitcnt lgkmcnt(0)" ::: "memory");
}
constexpr int I_IN = (DM / 64) * (NIN / 32), I_P = (DM / 64) * (DM / 32), NITEMS_A = I_IN + 3 * I_P;
constexpr int I_G = (DM / 64) * (DFF / 32), I_D = (DFF / 64) * (DM / 32), NITEMS_B = 2 * I_G + I_D;
__device__ __forceinline__ CvItem decode_A(PP p, int l, int it) {
    int r = it;
    if (r < I_IN) return CvItem{p->in[2] + (size_t)l * DM * NIN, (bf16*)(p->ws + WS_WIN), p->in[1] + (size_t)l * DM, DM, NIN, 1, r}; r -= I_IN;
    if (r < I_P) return CvItem{p->in[12] + (size_t)l * DM * DM, (bf16*)(p->ws + WS_WPAB), nullptr, DM, DM, 0, r}; r -= I_P;
    if (r < I_P) return CvItem{p->in[13] + (size_t)l * DM * DM, (bf16*)(p->ws + WS_WPAB) + (size_t)DM * DM, nullptr, DM, DM, 0, r}; r -= I_P;
    return CvItem{p->in[14] + (size_t)l * DM * DM, (bf16*)(p->ws + WS_WOUT), nullptr, DM, DM, 0, r};
}
__device__ __forceinline__ CvItem decode_B(PP p, int l, int it) {
    int r = it; const float* g = p->in[15] + (size_t)l * DM;
    if (r < I_G) return CvItem{p->in[16] + (size_t)l * DM * DFF, (bf16*)(p->ws + WS_WGU), g, DM, DFF, 2, r}; r -= I_G;
    if (r < I_G) return CvItem{p->in[17] + (size_t)l * DM * DFF, (bf16*)(p->ws + WS_WGU), g, DM, DFF, 3, r}; r -= I_G;
    return CvItem{p->in[18] + (size_t)l * DFF * DM, (bf16*)(p->ws + WS_WD), nullptr, DFF, DM, 0, r};
}
template <bool IS_A>
__device__ __forceinline__ void convert_AB(PP p, int l, LAS unsigned char* lds, int gw, int NGW, int wave, int lane) {
    LAS float* scr = (LAS float*)(lds + wave * 8704); constexpr int N = IS_A ? NITEMS_A : NITEMS_B;
    for (int base = gw; base < N; base += 3 * NGW) {
        CvItem d0 = IS_A ? decode_A(p, l, base) : decode_B(p, l, base), d1 = d0, d2 = d0; float w0[32], w1[32], w2[32];
        const bool ok1 = base + NGW < N, ok2 = base + 2 * NGW < N;
        cv_load(d0, lane, w0);
        if (ok1) { d1 = IS_A ? decode_A(p, l, base + NGW) : decode_B(p, l, base + NGW); cv_load(d1, lane, w1); }
        if (ok2) { d2 = IS_A ? decode_A(p, l, base + 2 * NGW) : decode_B(p, l, base + 2 * NGW); cv_load(d2, lane, w2); }
        cv_store(d0, scr, lane, w0);
        if (ok1) cv_store(d1, scr, lane, w1);
        if (ok2) cv_store(d2, scr, lane, w2);
    }
}
__device__ __forceinline__ void convert_A(PP p, int l, LAS unsigned char* lds, int gw, int NGW, int wave, int lane) { convert_AB<true>(p, l, lds, gw, NGW, wave, lane); }
__device__ __forceinline__ void convert_B(PP p, int l, LAS unsigned char* lds, int gw, int NGW, int wave, int lane) { convert_AB<false>(p, l, lds, gw, NGW, wave, lane); }
__device__ __forceinline__ void prologue(PP p, LAS unsigned char* lds, int gw, int NGW, int wave, int lane) {
    convert_A(p, 0, lds, gw, NGW, wave, lane);
    convert_B(p, 0, lds, gw, NGW, wave, lane);
    const int gt = gw * 64 + lane, NGT = NGW * 64;
    float* cosT = (float*)(p->ws + WS_COS); float* sinT = (float*)(p->ws + WS_SIN);
    for (int i = gt; i < SEQ * 32; i += NGT) { const int pos = i >> 5, j = i & 31;
        const float inv = exp2f(-(float)j * (13.287712379549449f / 32.0f));
        const float ang = (float)pos * inv;
        const double rev = (double)ang * 0.15915494309189535; const double fr = rev - floor(rev + 0.5);
        const float rad = (float)(fr * 6.283185307179586);
        cosT[i] = cosf(rad); sinT[i] = sinf(rad); }
    bf16* wsp = (bf16*)(p->ws + WS_WSP);
    for (int i = gt; i < DEPTH * 8 * 128 * 128; i += NGT) { const int s = i & 127, t = (i >> 7) & 127; const float w = p->in[10][i]; wsp[i] = (bf16)f2bf((t < 64 && s >= 64) ? 0.f : w); }
    const float* x = p->in[0]; bf16* XB = (bf16*)(p->ws + WS_XB); float* SS = (float*)(p->ws + WS_SS);
    for (int m = gw; m < T; m += NGW) {
        const f32x4* xr = (const f32x4*)(x + (size_t)m * DM) + lane; float s = 0.f;
        unsigned long long* o8 = (unsigned long long*)(XB + (size_t)m * DM) + lane;
#pragma unroll
        for (int j = 0; j < 4; ++j) { const f32x4 v = xr[64 * j]; s += (v[0] * v[0] + v[1] * v[1]) + (v[2] * v[2] + v[3] * v[3]);
            o8[64 * j] = (unsigned long long)pk2(v[0], v[1]) | ((unsigned long long)pk2(v[2], v[3]) << 32); }
        s = wave_sum(s);
        if (lane < 16) SS[(size_t)m * 16 + lane] = lane == 0 ? s : 0.f;
    }
}
__device__ __forceinline__ void final_norm(PP p, int gw, int NGW, int lane) {
    const float* g = p->in[19]; const bf16* XB = (const bf16*)(p->ws + WS_XB);
    for (int m = gw; m < T; m += NGW) {
        const u32x4* xr = (const u32x4*)(XB + (size_t)m * DM) + lane; f32x4* orow = (f32x4*)(p->out + (size_t)m * DM); float v[2][8]; float s = 0.f;
#pragma unroll
        for (int j = 0; j < 2; ++j) { const u32x4 w = xr[64 * j]; v[j][0] = bflo(w.x); v[j][1] = bfhi(w.x); v[j][2] = bflo(w.y); v[j][3] = bfhi(w.y); v[j][4] = bflo(w.z); v[j][5] = bfhi(w.z); v[j][6] = bflo(w.w); v[j][7] = bfhi(w.w);
#pragma unroll
            for (int e = 0; e < 8; ++e) s += v[j][e] * v[j][e]; }
        const float rs = rsqrtf(wave_sum(s) * (1.0f / DM) + 1e-6f);
#pragma unroll
        for (int j = 0; j < 2; ++j) { const int c = (lane + 64 * j) * 8; const f32x4 g0 = *(const f32x4*)(g + c), g1 = *(const f32x4*)(g + c + 4);
            orow[(c >> 2)] = (f32x4){v[j][0], v[j][1], v[j][2], v[j][3]} * rs * g0; orow[(c >> 2) + 1] = (f32x4){v[j][4], v[j][5], v[j][6], v[j][7]} * rs * g1; }
    }
}
#ifndef FORCE_BAD_EXPR
#define FORCE_BAD_EXPR
#endif
namespace att {
constexpr int KSTR = 144, VSTR = 320, KB = 2 * 64 * KSTR, VB_ = 64 * VSTR;
constexpr int OFF_K = 0, OFF_V = 2 * KB, OFF_WSF = OFF_V + 3 * VB_, OFF_END = OFF_WSF + NWAVES * 256;
static_assert(OFF_END <= 131072 && 65536 <= OFF_WSF, "attention LDS map");
__device__ __forceinline__ int crow(int r, int hi) { return (r & 3) + 8 * (r >> 2) + 4 * hi; }
typedef __bf16 bf16x2_t __attribute__((ext_vector_type(2)));
__device__ __forceinline__ unsigned cvtpk(float lo, float hi) { const f32x2 v = {lo, hi}; const bf16x2_t b = __builtin_convertvector(v, bf16x2_t); return __builtin_bit_cast(unsigned, b); }
__device__ __forceinline__ void qk_softmax(const LAS unsigned char* kst, const bf16x8 (&qr)[4], f32x16& negm, float& lsum, u32x4 (&pw)[4], bool first) {
    f32x16 p0, p1;
#pragma unroll
    for (int d0 = 0; d0 < 4; ++d0) {
        const bf16x8 k0 = *(const LAS bf16x8*)(kst + d0 * 32), k1 = *(const LAS bf16x8*)(kst + 32 * KSTR + d0 * 32);
        if (d0 == 0) { p0 = __builtin_amdgcn_mfma_f32_32x32x16_bf16(k0, qr[0], negm, 0, 0, 0); p1 = __builtin_amdgcn_mfma_f32_32x32x16_bf16(k1, qr[0], negm, 0, 0, 0); }
        else { p0 = __builtin_amdgcn_mfma_f32_32x32x16_bf16(k0, qr[d0], p0, 0, 0, 0); p1 = __builtin_amdgcn_mfma_f32_32x32x16_bf16(k1, qr[d0], p1, 0, 0, 0); }
    }
    if (first) {
        float rm = __builtin_fmaxf(__builtin_fmaxf(p0[0], p1[0]), p0[1]);
#pragma unroll
        for (int r = 1; r < 15; ++r) rm = __builtin_fmaxf(__builtin_fmaxf(rm, p1[r]), p0[r + 1]);
        rm = __builtin_fmaxf(rm, p1[15]);
        { auto rr = __builtin_amdgcn_permlane32_swap(__float_as_uint(rm), __float_as_uint(rm), false, false); rm = __builtin_fmaxf(__uint_as_float(rr[0]), __uint_as_float(rr[1])); }
        rm += 40.0f;
#pragma unroll
        for (int r = 0; r < 16; ++r) { p0[r] -= rm; p1[r] -= rm; negm[r] = -rm; }
    }
    float ps = 0.f;
#pragma unroll
    for (int r = 0; r < 16; ++r) { p0[r] = __builtin_amdgcn_exp2f(p0[r]); p1[r] = __builtin_amdgcn_exp2f(p1[r]); ps += p0[r] + p1[r]; }
    lsum += ps;
#pragma unroll
    for (int e = 0; e < 4; ++e) { pw[0][e] = cvtpk(p0[2 * e], p0[2 * e + 1]); pw[1][e] = cvtpk(p0[8 + 2 * e], p0[8 + 2 * e + 1]); pw[2][e] = cvtpk(p1[2 * e], p1[2 * e + 1]); pw[3][e] = cvtpk(p1[8 + 2 * e], p1[8 + 2 * e + 1]); }
}
__device__ __forceinline__ void qk_softmax_safe(const LAS unsigned char* kst, const bf16x8 (&qr)[4], f32x16 (&o)[4], float& mhat, float& lsum, u32x4 (&pw)[4], LAS float* wsf, int r32, int hi, bool first) {
    f32x16 p0, p1;
#pragma unroll
    for (int r = 0; r < 16; ++r) { p0[r] = 0.f; p1[r] = 0.f; }
#pragma unroll
    for (int d0 = 0; d0 < 4; ++d0) {
        const bf16x8 k0 = *(const LAS bf16x8*)(kst + d0 * 32), k1 = *(const LAS bf16x8*)(kst + 32 * KSTR + d0 * 32);
        p0 = __builtin_amdgcn_mfma_f32_32x32x16_bf16(k0, qr[d0], p0, 0, 0, 0);
        p1 = __builtin_amdgcn_mfma_f32_32x32x16_bf16(k1, qr[d0], p1, 0, 0, 0);
    }
#pragma unroll
    for (int r = 0; r < 16; ++r) { p0[r] -= mhat; p1[r] -= mhat; }
    float rm = __builtin_fmaxf(__builtin_fmaxf(p0[0], p1[0]), p0[1]);
    rm = __builtin_fmaxf(__builtin_fmaxf(rm, p1[1]), p0[2]);
#pragma unroll
    for (int r = 2; r < 16; r += 2) { rm = __builtin_fmaxf(__builtin_fmaxf(rm, p1[r]), p0[r + 1]); if (r + 2 < 16) rm = __builtin_fmaxf(__builtin_fmaxf(rm, p1[r + 1]), p0[r + 2]); else rm = __builtin_fmaxf(rm, p1[r + 1]); }
    { auto rr = __builtin_amdgcn_permlane32_swap(__float_as_uint(rm), __float_as_uint(rm), false, false); rm = __builtin_fmaxf(__uint_as_float(rr[0]), __uint_as_float(rr[1])); }
    if (first || __any(rm > 8.0f)) {
        const float dl = first ? rm : __builtin_fmaxf(rm, 0.f), f = first ? 0.f : __builtin_amdgcn_exp2f(-dl); mhat += dl; lsum *= f;
#pragma unroll
        for (int r = 0; r < 16; ++r) { p0[r] -= dl; p1[r] -= dl; }
        if (hi == 0) wsf[r32] = f;
        asm volatile("s_waitcnt lgkmcnt(0)" ::: "memory");
#pragma unroll
        for (int r = 0; r < 16; ++r) { const float fr_ = wsf[crow(r, hi)];
#pragma unroll
            for (int d = 0; d < 4; ++d) o[d][r] *= fr_; }
        asm volatile("s_waitcnt lgkmcnt(0)" ::: "memory");
    }
    float ps = 0.f;
#pragma unroll
    for (int r = 0; r < 16; ++r) { p0[r] = __builtin_amdgcn_exp2f(p0[r]); p1[r] = __builtin_amdgcn_exp2f(p1[r]); ps += p0[r] + p1[r]; }
    lsum += ps;
#pragma unroll
    for (int e = 0; e < 4; ++e) { pw[0][e] = cvtpk(p0[2 * e], p0[2 * e + 1]); pw[1][e] = cvtpk(p0[8 + 2 * e], p0[8 + 2 * e + 1]); pw[2][e] = cvtpk(p1[2 * e], p1[2 * e + 1]); pw[3][e] = cvtpk(p1[8 + 2 * e], p1[8 + 2 * e + 1]); }
}
#define ATT_VRD(buf, ks) do { _Pragma("unroll") for (int d = 0; d < 4; ++d) { \
        lo[buf][d] = __builtin_bit_cast(s16x4, __builtin_amdgcn_ds_read_tr16_b64_v4i16((LAS s16x4*)(vb + (ks) * 16 * VSTR + d * 64))); \
        up[buf][d] = __builtin_bit_cast(s16x4, __builtin_amdgcn_ds_read_tr16_b64_v4i16((LAS s16x4*)(vb + (ks) * 16 * VSTR + 8 * VSTR + d * 64))); } } while (0)
#define ATT_VMM(buf, ks) do { _Pragma("unroll") for (int d = 0; d < 4; ++d) { \
        const bf16x8 vf = (bf16x8){lo[buf][d][0], lo[buf][d][1], lo[buf][d][2], lo[buf][d][3], up[buf][d][0], up[buf][d][1], up[buf][d][2], up[buf][d][3]}; \
        o[d] = __builtin_amdgcn_mfma_f32_32x32x16_bf16(__builtin_bit_cast(bf16x8, pw[ks]), vf, o[d], 0, 0, 0); } } while (0)
__device__ __forceinline__ void pv_tile(const LAS unsigned char* vb, const u32x4 (&pw)[4], f32x16 (&o)[4]) {
    s16x4 lo[2][4], up[2][4];
    __builtin_amdgcn_sched_barrier(0);
    ATT_VRD(0, 0); __builtin_amdgcn_sched_barrier(0);
    ATT_VRD(1, 1); __builtin_amdgcn_sched_barrier(0);
    ATT_VMM(0, 0); __builtin_amdgcn_sched_barrier(0);
    ATT_VRD(0, 2); __builtin_amdgcn_sched_barrier(0);
    ATT_VMM(1, 1); __builtin_amdgcn_sched_barrier(0);
    ATT_VRD(1, 3); __builtin_amdgcn_sched_barrier(0);
    ATT_VMM(0, 2); __builtin_amdgcn_sched_barrier(0);
    ATT_VMM(1, 3); __builtin_amdgcn_sched_barrier(0);
}
#undef ATT_VRD
#undef ATT_VMM
template <bool SAFE>
__device__ __forceinline__ bool attn_unit(int b, int h, int qb, int qb_next, u32x4& sk0, u32x4& sk1, u32x4& sv0, u32x4& sv1, bf16x8 (&qr)[4], bf16* QO, const bf16* __restrict__ Kg, const bf16* __restrict__ Vg, float lam, float oscale, const float* __restrict__ subg, LAS unsigned char* lds, bool dry = false) {
    int tid_ = threadIdx.x; asm volatile("" : "+v"(tid_));
    const int tid = tid_, lane = tid & 63, r32 = lane & 31, hi = lane >> 5; const int w = __builtin_amdgcn_readfirstlane(tid >> 6), mi = w >> 2, rb = w & 3;
    const size_t rowbase = (size_t)b * SEQ; const int q0 = qb * 128;
    const int NT = 2 * qb + 2, ntw = 2 * qb + 1 + (rb >> 1);
    const int skey = tid >> 4, sch = tid & 15;
    const bf16* kgp = Kg + (rowbase + skey) * DM + h * 128 + sch * 8; const bf16* vgp = Vg + (rowbase + skey) * DM + h * 128 + sch * 8;
    const int kls = OFF_K + (sch >> 3) * (64 * KSTR) + skey * KSTR + (sch & 7) * 16, vls = OFF_V + skey * VSTR + sch * 16;
#define LOADT(t) do { const size_t o_ = (size_t)(t) * 64 * DM; sk0 = *(const u32x4*)(kgp + o_); sk1 = *(const u32x4*)(kgp + o_ + 32 * DM); sv0 = *(const u32x4*)(vgp + o_); sv1 = *(const u32x4*)(vgp + o_ + 32 * DM); } while (0)
#define STORET(kb, vb3) do { *(LAS u32x4*)(lds + (kb) * KB + kls) = sk0; *(LAS u32x4*)(lds + (kb) * KB + kls + 32 * KSTR) = sk1; *(LAS u32x4*)(lds + (vb3) + vls) = sv0; *(LAS u32x4*)(lds + (vb3) + vls + 32 * VSTR) = sv1; } while (0)
    if (SAFE) {
        LOADT(0);
        const bf16* qp = QO + (rowbase + q0 + rb * 32 + r32) * DM + h * 128 + mi * 64 + hi * 8;
#pragma unroll
        for (int d0 = 0; d0 < 4; ++d0) qr[d0] = *(const bf16x8*)(qp + d0 * 16);
    }
    STORET(0, 0);
    __syncthreads();
    f32x16 o[4];
#pragma unroll
    for (int d = 0; d < 4; ++d)
#pragma unroll
        for (int r = 0; r < 16; ++r) o[d][r] = 0.f;
    float lsum = 0.f, mhat = 0.f; f32x16 negm;
#pragma unroll
    for (int r = 0; r < 16; ++r) negm[r] = 0.f;
    u32x4 pw[4];
#pragma unroll
    for (int i = 0; i < 4; ++i) pw[i] = (u32x4){0u, 0u, 0u, 0u};
    LAS float* wsf = (LAS float*)(lds + OFF_WSF + w * 256);
    const unsigned kfo = OFF_K + mi * (64 * KSTR) + r32 * KSTR + hi * 16;
    const unsigned vfo = OFF_V + (4 * hi + ((lane & 15) >> 2)) * VSTR + (((lane >> 4) & 1) * 16 + (lane & 3) * 4) * 2;
    int vcur = 0, vprev = 2 * VB_, vnext = VB_;
    for (int t = 0; t < NT; ++t) {
        if (t + 1 < NT) LOADT(t + 1);
        if (mi == 1 && t >= 1 && t - 1 < ntw) pv_tile(lds + vprev + vfo, pw, o);
        if (t < ntw) { if (SAFE) qk_softmax_safe(lds + (t & 1) * KB + kfo, qr, o, mhat, lsum, pw, wsf, r32, hi, t == 0); else qk_softmax(lds + (t & 1) * KB + kfo, qr, negm, lsum, pw, t == 0); }
        if (mi == 0 && t < ntw) pv_tile(lds + vcur + vfo, pw, o);
        if (t + 1 < NT) STORET((t + 1) & 1, vnext);
        __syncthreads();
        { const int tmp = vprev; vprev = vcur; vcur = vnext; vnext = tmp; }
    }
    if (mi == 1 && ntw == NT) pv_tile(lds + vprev + vfo, pw, o);
    float gsub[4];
#pragma unroll
    for (int d = 0; d < 4; ++d) gsub[d] = subg[d * 32 + r32] * oscale;
    if (qb_next >= 0) {
        LOADT(0);
        const bf16* qp = QO + (rowbase + qb_next * 128 + rb * 32 + r32) * DM + h * 128 + mi * 64 + hi * 8;
#pragma unroll
        for (int d0 = 0; d0 < 4; ++d0) qr[d0] = *(const bf16x8*)(qp + d0 * 16);
    }
#undef LOADT
#undef STORET
    if (!SAFE) { const bool wbad = __any(!(lsum < 1.0e30f)) FORCE_BAD_EXPR; if (lane == 0) wsf[63] = wbad ? 1.0f : 0.0f; }
    __syncthreads();
    bool bad = false;
    if (!SAFE) { float fl = 0.f;
#pragma unroll
        for (int i = 0; i < NWAVES; ++i) fl += ((LAS float*)(lds + OFF_WSF + i * 256))[63];
        bad = fl > 0.f; }
    { auto rr = __builtin_amdgcn_permlane32_swap(__float_as_uint(lsum), __float_as_uint(lsum), false, false); lsum = __uint_as_float(rr[0]) + __uint_as_float(rr[1]); }
    if (hi == 0) wsf[r32] = (mi ? -lam : 1.0f) / lsum;
    asm volatile("s_waitcnt lgkmcnt(0)" ::: "memory");
#pragma unroll
    for (int r = 0; r < 16; ++r) { const float fr_ = wsf[crow(r, hi)];
#pragma unroll
        for (int d = 0; d < 4; ++d) o[d][r] *= fr_; }
    LAS float* xch = (LAS float*)lds + rb * (4 * 16 * 64);
    if (mi == 1) {
#pragma unroll
        for (int d = 0; d < 4; ++d)
#pragma unroll
            for (int r = 0; r < 16; ++r) xch[(d * 16 + r) * 64 + lane] = o[d][r];
    }
    __syncthreads();
    if (mi == 0 && !dry && !bad) {
        bf16* op = QO + (rowbase + q0 + rb * 32) * DM + h * 128 + r32;
#pragma unroll
        for (int r = 0; r < 16; ++r) {
            float ss = 0.f;
#pragma unroll
            for (int d = 0; d < 4; ++d) { o[d][r] += xch[(d * 16 + r) * 64 + lane]; ss += o[d][r] * o[d][r]; }
            ss += __shfl_xor(ss, 1); ss += __shfl_xor(ss, 2); ss += __shfl_xor(ss, 4); ss += __shfl_xor(ss, 8); ss += __shfl_xor(ss, 16);
            const float rs = rsqrtf(ss * (1.0f / 128.0f) + 1e-6f);
#pragma unroll
            for (int d = 0; d < 4; ++d) op[(size_t)crow(r, hi) * DM + d * 32] = (bf16)f2bf(o[d][r] * rs * gsub[d]);
        }
    }
    __syncthreads();
    return bad;
}
constexpr int SG_STAT = 0, SG_V = 1024, SG_M = SG_V + 128 * VSTR, SG_W = SG_M + 128 * 132 * 4, WSTR = 272, SG_END = SG_W + 128 * WSTR;
static_assert(SG_END <= 147392, "sgu LDS map");
__device__ __forceinline__ void sgu_unit(int n, int g, bf16* UO, const bf16* __restrict__ VBp, const float* __restrict__ VST, const bf16* __restrict__ Wm, const float* __restrict__ bs,
                                         const float* __restrict__ lng, const float* __restrict__ lnb, LAS unsigned char* lds) {
    int tid_ = threadIdx.x; asm volatile("" : "+v"(tid_));
    const int tid = tid_, lane = tid & 63, r32 = lane & 31, hi = lane >> 5; const int w = __builtin_amdgcn_readfirstlane(tid >> 6);
    const size_t row0 = (size_t)n * 128; const int ch = tid & 15, tb = w & 3, cb0 = (w >> 2) * 2;
    f32x4 st8[8];
    if (tid < 128) { const f32x4* sp = (const f32x4*)(VST + (row0 + tid) * 32);
#pragma unroll
        for (int i = 0; i < 8; ++i) st8[i] = sp[i]; }
    u32x4 vv[4], uu[4]; bf16* up_[4];
#pragma unroll
    for (int i = 0; i < 4; ++i) { const int row = (tid >> 4) + 32 * i; vv[i] = *(const u32x4*)(VBp + (row0 + row) * DM + g * 128 + ch * 8); up_[i] = UO + (row0 + row) * DM + g * 128 + ch * 8; uu[i] = *(const u32x4*)up_[i]; }
    const f32x4 gg0 = *(const f32x4*)(lng + g * 128 + ch * 8), gg1 = *(const f32x4*)(lng + g * 128 + ch * 8 + 4), bb0 = *(const f32x4*)(lnb + g * 128 + ch * 8), bb1 = *(const f32x4*)(lnb + g * 128 + ch * 8 + 4);
    u32x4 ww[4];
#pragma unroll
    for (int i = 0; i < 4; ++i) ww[i] = *(const u32x4*)(Wm + (size_t)g * 128 * 128 + (size_t)((tid >> 4) + 32 * i) * 128 + ch * 8);
    f32x4 bs4[4];
#pragma unroll
    for (int k = 0; k < 4; ++k) bs4[k] = *(const f32x4*)(bs + g * 128 + tb * 32 + 8 * k + 4 * hi);
    LAS f32x2* stat = (LAS f32x2*)(lds + SG_STAT);
    if (tid < 128) { float s1 = 0.f, s2 = 0.f;
#pragma unroll
        for (int i = 0; i < 8; ++i) { s1 += st8[i][0] + st8[i][2]; s2 += st8[i][1] + st8[i][3]; }
        const float mu = s1 * (1.0f / 1024.0f), var = fmaxf(s2 * (1.0f / 1024.0f) - mu * mu, 0.f);
        stat[tid] = (f32x2){mu, rsqrtf(var + 1e-6f)}; }
    __syncthreads();
    { const float gg[8] = {gg0[0], gg0[1], gg0[2], gg0[3], gg1[0], gg1[1], gg1[2], gg1[3]}, bb[8] = {bb0[0], bb0[1], bb0[2], bb0[3], bb1[0], bb1[1], bb1[2], bb1[3]};
#pragma unroll
      for (int i = 0; i < 4; ++i) { const int row = (tid >> 4) + 32 * i; const u32x4 v = vv[i]; const f32x2 st = stat[row];
          float f[8] = {bflo(v.x), bfhi(v.x), bflo(v.y), bfhi(v.y), bflo(v.z), bfhi(v.z), bflo(v.w), bfhi(v.w)};
#pragma unroll
          for (int e = 0; e < 8; ++e) f[e] = (f[e] - st.x) * st.y * gg[e] + bb[e];
          u32x4 o; o.x = pk2(f[0], f[1]); o.y = pk2(f[2], f[3]); o.z = pk2(f[4], f[5]); o.w = pk2(f[6], f[7]);
          *(LAS u32x4*)(lds + SG_V + row * VSTR + ch * 16) = o;
          *(LAS u32x4*)(lds + SG_W + row * WSTR + ch * 16) = ww[i]; } }
    __syncthreads();
    f32x16 acc[2];
#pragma unroll
    for (int j = 0; j < 2; ++j)
#pragma unroll
        for (int r = 0; r < 16; ++r) acc[j][r] = 0.f;
    const LAS unsigned char* vb = lds + SG_V + (8 * hi + ((lane & 15) >> 2)) * VSTR + (((lane >> 4) & 1) * 16 + (lane & 3) * 4) * 2;
#pragma unroll
    for (int ks = 0; ks < 8; ++ks) {
        if (ks < 4 || tb >= 2) {
            const bf16x8 af = *(const LAS bf16x8*)(lds + SG_W + (tb * 32 + r32) * WSTR + (ks * 16 + hi * 8) * 2);
#pragma unroll
            for (int j = 0; j < 2; ++j) {
                const s16x4 lo = __builtin_bit_cast(s16x4, __builtin_amdgcn_ds_read_tr16_b64_v4i16((LAS s16x4*)(vb + ks * 16 * VSTR + (cb0 + j) * 64)));
                const s16x4 up = __builtin_bit_cast(s16x4, __builtin_amdgcn_ds_read_tr16_b64_v4i16((LAS s16x4*)(vb + ks * 16 * VSTR + 4 * VSTR + (cb0 + j) * 64)));
                const bf16x8 vf = (bf16x8){lo[0], lo[1], lo[2], lo[3], up[0], up[1], up[2], up[3]};
                acc[j] = __builtin_amdgcn_mfma_f32_32x32x16_bf16(af, vf, acc[j], 0, 0, 0);
            }
        }
    }
    LAS float* M = (LAS float*)(lds + SG_M);
#pragma unroll
    for (int j = 0; j < 2; ++j)
#pragma unroll
        for (int r = 0; r < 16; ++r) { const int t = tb * 32 + crow(r, hi); M[t * 132 + (cb0 + j) * 32 + r32] = acc[j][r] + bs4[r >> 2][r & 3]; }
    __syncthreads();
#pragma unroll
    for (int i = 0; i < 4; ++i) { const int row = (tid >> 4) + 32 * i; const u32x4 v = uu[i];
        const f32x4 m0 = *(const LAS f32x4*)(M + row * 132 + ch * 8), m1 = *(const LAS f32x4*)(M + row * 132 + ch * 8 + 4);
        u32x4 o; o.x = pk2(bflo(v.x) * m0[0], bfhi(v.x) * m0[1]); o.y = pk2(bflo(v.y) * m0[2], bfhi(v.y) * m0[3]); o.z = pk2(bflo(v.z) * m1[0], bfhi(v.z) * m1[1]); o.w = pk2(bflo(v.w) * m1[2], bfhi(v.w) * m1[3]);
        *(u32x4*)up_[i] = o; }
    __syncthreads();
}
}
#define RLX_AGENT __ATOMIC_RELAXED, __HIP_MEMORY_SCOPE_AGENT
#define LDS_WAIT() asm volatile("s_waitcnt lgkmcnt(0)" ::: "memory")
#define VM_WAIT() asm volatile("s_waitcnt vmcnt(0)" ::: "memory")
#define XB_TMO      128
#define XB_XCNT(j)  (256  + 64 * (j))
#define XB_XSUB(j)  (1280 + 64 * (j))
#define XB_XGEN(j)  (2304 + 64 * (j))
#define XB_TOP      3328
#define XB_TOPGEN   3392
#define XCD_BAR_WORDS 3456
#define XB_SPIN_CAP (1u << 18)

__device__ __forceinline__ unsigned xb_ld(unsigned* p)              { return __hip_atomic_load(p, __ATOMIC_RELAXED, __HIP_MEMORY_SCOPE_AGENT); }
__device__ __forceinline__ unsigned xb_add(unsigned* p, unsigned v) { return __hip_atomic_fetch_add(p, v, __ATOMIC_RELAXED, __HIP_MEMORY_SCOPE_AGENT); }
__device__ __forceinline__ unsigned xb_xcc_id() { return (unsigned)__builtin_amdgcn_s_getreg((3 << 11) | 20) & 0xFu; }
#define XB_SPIN(cond, bar) do { unsigned _sp = 0; while (cond) { __builtin_amdgcn_s_sleep(1); \
    if ((++_sp & 255u) == 0u) { if (xb_ld(&(bar)[XB_TMO])) break; if (_sp > XB_SPIN_CAP) { atomicAdd(&(bar)[XB_TMO], 1u); break; } } } } while (0)

struct XcdBarrier {
    unsigned* bar; unsigned x;
    volatile LAS unsigned* st;
};

__device__ __forceinline__ XcdBarrier xcd_barrier_post(unsigned* bar, volatile LAS unsigned* st) {
    XcdBarrier b; b.bar = bar; b.x = xb_xcc_id(); b.st = st;
    if (threadIdx.x == 0) (void)xb_add(&bar[XB_XCNT(b.x)], 1u);
    return b;
}
__device__ __forceinline__ void xcd_barrier_complete(unsigned* bar, unsigned x, unsigned& nloc, unsigned& nx) {
    const unsigned G = gridDim.x * gridDim.y * gridDim.z;
    unsigned sum, cnt, mine, sp = 0u;
    for (;;) {
        sum = 0u; cnt = 0u; mine = 0u;
#pragma unroll
        for (unsigned j = 0; j < 16; ++j) { const unsigned c = xb_ld(&bar[XB_XCNT(j)]); sum += c; cnt += (c > 0u) ? 1u : 0u; mine = (j == x) ? c : mine; }
        if (sum == G) break;
        __builtin_amdgcn_s_sleep(1);
        if ((++sp & 255u) == 0u) { if (xb_ld(&bar[XB_TMO])) break; if (sp > XB_SPIN_CAP) { atomicAdd(&bar[XB_TMO], 1u); break; } }
    }
    nloc = mine > 0u ? mine : 1u; nx = cnt > 0u ? cnt : 1u;
}

__device__ __forceinline__ void xcd_barrier(const XcdBarrier& b) {
    asm volatile("s_waitcnt vmcnt(0)" ::: "memory");
    __syncthreads();
    if (threadIdx.x == 0) {
        unsigned* bar = b.bar;
        __builtin_amdgcn_s_waitcnt(0);
        unsigned nloc = b.st[0], nx = b.st[1];
        if (nloc == 0u) { xcd_barrier_complete(bar, b.x, nloc, nx); b.st[0] = nloc; b.st[1] = nx; }
        const unsigned old = xb_add(&bar[XB_XSUB(b.x)], 1u);
        const unsigned gen = old / nloc;
        if (old + 1u == (gen + 1u) * nloc) {
            __builtin_amdgcn_fence(__ATOMIC_RELEASE, "agent");
            asm volatile("s_waitcnt vmcnt(0)" ::: "memory");
            const unsigned og = xb_add(&bar[XB_TOP], 1u);
            const unsigned tg = og / nx;
            if (og + 1u == (tg + 1u) * nx) xb_add(&bar[XB_TOPGEN], 1u);
            else XB_SPIN(xb_ld(&bar[XB_TOPGEN]) == tg, bar);
            __builtin_amdgcn_fence(__ATOMIC_ACQUIRE, "agent");
            xb_add(&bar[XB_XGEN(b.x)], 1u);
            asm volatile("s_waitcnt vmcnt(0)" ::: "memory");
        } else {
            XB_SPIN(xb_ld(&bar[XB_XGEN(b.x)]) == gen, bar);
            __builtin_amdgcn_fence(__ATOMIC_ACQUIRE, "agent");
            asm volatile("s_waitcnt vmcnt(0)" ::: "memory");
        }
    }
    __syncthreads();
}

constexpr int LDS_RTAB = 131072;
template <int NU>
__device__ __forceinline__ void rstd_table(const pg8::StaticOrder& S, const float* SS, LAS unsigned char* lds, int tid) {
    static_assert(NU * 256 * 4 <= 147392 - LDS_RTAB, "rstd table fits above the ring");
    f32x4 a[NU][2]; const int row = tid >> 1, half = tid & 1;
#pragma unroll
    for (int i = 0; i < NU; ++i) { pg8::Unit u; if (S.next(i, u)) { const f32x4* sp = (const f32x4*)(SS + ((size_t)u.pm * 256 + row) * 16 + 8 * half); a[i][0] = sp[0]; a[i][1] = sp[1]; } else { a[i][0] = (f32x4){1.f, 0.f, 0.f, 0.f}; a[i][1] = (f32x4){0.f, 0.f, 0.f, 0.f}; } }
#pragma unroll
    for (int i = 0; i < NU; ++i) { float s = ((a[i][0][0] + a[i][0][1]) + (a[i][0][2] + a[i][0][3])) + ((a[i][1][0] + a[i][1][1]) + (a[i][1][2] + a[i][1][3]));
        s += __shfl_xor(s, 1);
        if (half == 0) ((LAS float*)(lds + LDS_RTAB))[i * 256 + row] = rsqrtf(s * (1.0f / 1024.0f) + 1e-6f); }
    __syncthreads();
}
constexpr int NPH = 2 + 6 * DEPTH;
#ifndef ONE_LAUNCH
#define ONE_LAUNCH 1
#endif
__global__ void __launch_bounds__(NTHR, 2) fwd_megakernel(Params p_unused) {
    extern __shared__ __attribute__((aligned(16))) unsigned char lds_raw[];
    LAS unsigned char* lds = (LAS unsigned char*)lds_raw;
    int ph_lo, ph_hi;
    { PP p = (PP)__builtin_amdgcn_kernarg_segment_ptr(); ph_lo = p->ph_lo; ph_hi = p->ph_hi; }
#if ONE_LAUNCH
    if (threadIdx.x < 16) ((LAS unsigned*)(lds + LDS_XB))[threadIdx.x] = 0u;
    __syncthreads();
    { PP p = (PP)__builtin_amdgcn_kernarg_segment_ptr(); (void)xcd_barrier_post((unsigned*)(p->ws + WS_CTL), (volatile LAS unsigned*)(lds + LDS_XB)); }
#endif
    for (int ph = ph_lo; ph < ph_hi; ++ph) {
        PP p = (PP)__builtin_amdgcn_kernarg_segment_ptr(); asm volatile("" : "+s"(p));
        int tid_ = threadIdx.x; asm volatile("" : "+v"(tid_));
        const int tid = tid_, lane = tid & 63, wave = __builtin_amdgcn_readfirstlane(tid >> 6);
        const int G = gridDim.x, bx = blockIdx.x, vcu = (G % 8 == 0) ? (bx % 8) * (G / 8) + bx / 8 : bx;
        const int gw = vcu * NWAVES + wave, NGW = G * NWAVES;
        unsigned char* ws = p->ws;
        if (ph == 0) {
            prologue(p, lds, gw, NGW, wave, lane);
        } else if (ph == NPH - 1) {
            final_norm(p, gw, NGW, lane);
        } else {
            const int l = (ph - 1) / 6, k = (ph - 1) % 6;
            if (k == 0) {
                pg8::Gemm g{(const bf16*)(ws + WS_XB), (const bf16*)(ws + WS_WIN), T, NIN, DM}; pg8::StaticOrder S; S.init(T, NIN, G, bx);
                rstd_table<14>(S, (const float*)(ws + WS_SS), lds, tid);
                pg8::EpiIn E{(const float*)(ws + WS_SS), (const float*)(ws + WS_COS), (const float*)(ws + WS_SIN), (bf16*)(ws + WS_Q), (bf16*)(ws + WS_K), (bf16*)(ws + WS_VA), (bf16*)(ws + WS_U), (bf16*)(ws + WS_VB), ws + WS_GA, ws + WS_GB, (float*)(ws + WS_VST), (const LAS float*)(lds + LDS_RTAB), 14};
                pg8::gemm_phase<pg8::EpiIn, pg8::StaticOrder, true, true>(lds, g, S, E);
            } else if (k == 1) {
                if (l > 0) { convert_B(p, l, lds, gw, NGW, wave, lane); __syncthreads(); }
                float sa = p->in[3][l * 64 + lane] * p->in[4][l * 64 + lane], sb = p->in[5][l * 64 + lane] * p->in[6][l * 64 + lane];
                sa = wave_sum(sa); sb = wave_sum(sb);
                const float lam_init = 0.8f - 0.6f * __expf(-0.3f * (float)l);
                const float lam = __expf(sa) - __expf(sb) + lam_init;
                for (int v = vcu; v < 256; v += G) {
                    for (int gi = 0; gi < 8; ++gi)
                        att::sgu_unit(v, gi, (bf16*)(ws + WS_U), (const bf16*)(ws + WS_VB), (const float*)(ws + WS_VST), (const bf16*)(ws + WS_WSP) + (size_t)l * 8 * 128 * 128, p->in[11] + (size_t)l * 8 * 128, p->in[8] + (size_t)l * DM, p->in[9] + (size_t)l * DM, lds);
                    const int bh = v >> 2, j = v & 3;
                    u32x4 sk0, sk1, sv0, sv1; bf16x8 qr[4]; unsigned badmask = 0u;
                    {
                        const int w_ = wave, mi_ = w_ >> 2, rb_ = w_ & 3, r32_ = lane & 31, hi_ = lane >> 5, skey = tid >> 4, sch = tid & 15; const size_t rowbase = (size_t)(bh >> 3) * SEQ; const int h_ = bh & 7;
                        const bf16* kgp = (const bf16*)(ws + WS_K) + (rowbase + skey) * DM + h_ * 128 + sch * 8; const bf16* vgp = (const bf16*)(ws + WS_VA) + (rowbase + skey) * DM + h_ * 128 + sch * 8;
                        sk0 = *(const u32x4*)kgp; sk1 = *(const u32x4*)(kgp + 32 * DM); sv0 = *(const u32x4*)vgp; sv1 = *(const u32x4*)(vgp + 32 * DM);
                        const bf16* qp = (const bf16*)(ws + WS_Q) + (rowbase + j * 128 + rb_ * 32 + r32_) * DM + h_ * 128 + mi_ * 64 + hi_ * 8;
#pragma unroll
                        for (int d0 = 0; d0 < 4; ++d0) qr[d0] = *(const bf16x8*)(qp + d0 * 16); }
                    for (int i = 0; i < 8; ++i) { const int s = j + 4 * (i >> 1), qb = (i & 1) ? 31 - s : s; const int s2 = j + 4 * ((i + 1) >> 1), qbn = i + 1 < 8 ? (((i + 1) & 1) ? 31 - s2 : s2) : -1;
                        if (att::attn_unit<false>(bh >> 3, bh & 7, qb, qbn, sk0, sk1, sv0, sv1, qr, (bf16*)(ws + WS_Q), (const bf16*)(ws + WS_K), (const bf16*)(ws + WS_VA), lam, 1.0f - lam_init, p->in[7] + (size_t)l * 128, lds)) badmask |= 1u << i; }
                    for (int i = 0; i < 8; ++i) if ((badmask >> i) & 1u) { const int s = j + 4 * (i >> 1), qb = (i & 1) ? 31 - s : s;
                        (void)att::attn_unit<true>(bh >> 3, bh & 7, qb, -1, sk0, sk1, sv0, sv1, qr, (bf16*)(ws + WS_Q), (const bf16*)(ws + WS_K), (const bf16*)(ws + WS_VA), lam, 1.0f - lam_init, p->in[7] + (size_t)l * 128, lds); }
                }
            } else if (k == 2) {
                pg8::Gemm g{(const bf16*)(ws + WS_Q), (const bf16*)(ws + WS_WPAB), 2 * T, 2 * DM, DM}; pg8::ProjOrder S; S.init(T, DM, G, bx);
                pg8::EpiProj E{ws + WS_GA, ws + WS_GB, (bf16*)(ws + WS_Y)};
                pg8::gemm_phase<pg8::EpiProj, pg8::ProjOrder, true, true>(lds, g, S, E);
            } else if (k == 3 || k == 5) {
                pg8::Gemm g{(const bf16*)(ws + (k == 3 ? WS_Y : WS_H)), (const bf16*)(ws + (k == 3 ? WS_WOUT : WS_WD)), T, DM, k == 3 ? DM : DFF}; pg8::StaticOrder S; S.init(T, DM, G, bx);
                pg8::EpiRes E{(bf16*)(ws + WS_XB), (float*)(ws + WS_SS)};
                pg8::gemm_phase<pg8::EpiRes, pg8::StaticOrder, true, true>(lds, g, S, E);
            } else {
                if (l + 1 < DEPTH) { convert_A(p, l + 1, lds, gw, NGW, wave, lane); __syncthreads(); }
                pg8::Gemm g{(const bf16*)(ws + WS_XB), (const bf16*)(ws + WS_WGU), T, NGU, DM}; pg8::StaticOrder S; S.init(T, NGU, G, bx);
                rstd_table<11>(S, (const float*)(ws + WS_SS), lds, tid);
                pg8::EpiGU E{(const float*)(ws + WS_SS), (bf16*)(ws + WS_H), (const LAS float*)(lds + LDS_RTAB), 11};
                pg8::gemm_phase<pg8::EpiGU, pg8::StaticOrder, true, true>(lds, g, S, E);
            }
        }
        if (ph + 1 < ph_hi) {
            if (ph_hi > 4096) cg::this_grid().sync();
            else { XcdBarrier xb; xb.bar = (unsigned*)(p->ws + WS_CTL); xb.x = xb_xcc_id(); xb.st = (volatile LAS unsigned*)(lds + LDS_XB); xcd_barrier(xb); }
        }
    }
}

extern "C" void kernel_launch(void* const* d_in, const int* in_sizes, int n_in, void* d_out, int out_size, void* d_ws, size_t ws_size, hipStream_t stream) {
    static int grid = 0;
    if (grid == 0) {
        if (n_in != 20 || in_sizes[0] != T * DM || out_size != T * DM || ws_size < WS_END) { fprintf(stderr, "kernel_launch: unexpected shapes / workspace (n_in %d, ws %zu)\n", n_in, ws_size); grid = -1; return; }
        int dev = 0, cus = 0, per_cu = 0;
        if (hipGetDevice(&dev) != hipSuccess || hipDeviceGetAttribute(&cus, hipDeviceAttributeMultiprocessorCount, dev) != hipSuccess) { grid = -1; return; }
        if (hipFuncSetAttribute((const void*)fwd_megakernel, hipFuncAttributeMaxDynamicSharedMemorySize, LDS_BYTES) != hipSuccess) { fprintf(stderr, "kernel_launch: hipFuncSetAttribute failed\n"); grid = -1; return; }
        if (hipOccupancyMaxActiveBlocksPerMultiprocessor(&per_cu, (const void*)fwd_megakernel, NTHR, LDS_BYTES) != hipSuccess || per_cu < 1) per_cu = 1;
        (void)hipGetLastError();
        grid = cus * per_cu;
    }
    if (grid < 0) return;
    Params p{};
    for (int i = 0; i < 20; ++i) p.in[i] = (const float*)d_in[i];
    p.out = (float*)d_out; p.ws = (unsigned char*)d_ws;
#if ONE_LAUNCH
    (void)hipMemsetAsync((char*)d_ws + WS_CTL, 0, CTL_ZERO_BYTES, stream);
    p.ph_lo = 0; p.ph_hi = NPH;
    void* args[] = {&p};
    hipError_t e = hipLaunchCooperativeKernel((const void*)fwd_megakernel, dim3(grid), dim3(NTHR), args, LDS_BYTES, stream);
    if (e != hipSuccess) fprintf(stderr, "cooperative launch failed: %s (grid %d)\n", hipGetErrorString(e), grid);
#else
    for (int ph = 0; ph < NPH; ++ph) { p.ph_lo = ph; p.ph_hi = ph + 1; hipLaunchKernelGGL(fwd_megakernel, dim3(grid), dim3(NTHR), LDS_BYTES, stream, p); }
#endif
}
```

```cpp
#include <hip/hip_runtime.h>
#include <hip/hip_cooperative_groups.h>
#include <cstdio>
#include <cstdint>
namespace cg = cooperative_groups;
namespace pg8 {
#define PG8_LAS __attribute__((address_space(3)))
typedef unsigned short bf16_t;
typedef short bf16x8 __attribute__((ext_vector_type(8)));
typedef float f32x4 __attribute__((ext_vector_type(4)));
typedef unsigned u32x4 __attribute__((ext_vector_type(4)));
constexpr int BM = 256, BK = 64, HALF = 128, HTB = HALF * BK * 2  , STAGE_BYTES = 8 * HTB, NXCD = 8, WGM = 8;

__host__ __device__ __forceinline__ int lds_byte(int r, int c) { const int st = (r >> 4) * 2 + (c >> 5), rr = r & 15, cc = c & 31, ob = rr * 64 + cc * 2; return st * 1024 + (ob ^ (((ob >> 9) & 1) << 5)); }
__host__ __device__ __forceinline__ void stage_rc(int b, int& R, int& C) { const int st = b / 1024, sb = b % 1024, swz = sb ^ (((sb >> 9) & 1) << 5); R = (st >> 1) * 16 + swz / 64; C = (st & 1) * 32 + (swz % 64) / 2; }
__host__ __device__ __forceinline__ int perm32(int rho) { const int n = rho >> 4, i = rho & 15; return 8 * (i >> 2) + 4 * n + (i & 3); }

struct Unit { int pm, pn, ord; };
struct Gemm { const bf16_t* A; const bf16_t* Bt; int M, N, K; };

struct StaticOrder {
    int nM, nN, nwg, G, c;
    __host__ __device__ void init(int M, int N, int G_, int c_) { nM = M / BM; nN = N / BM; nwg = nM * nN; G = G_; c = c_; }
    __host__ __device__ bool next(int i, Unit& u) const {
        const long L = (long)i * G + c; if (L >= nwg) return false;
        int wgid = (int)L; { const int q = nwg / NXCD, r = nwg % NXCD, xcd = wgid % NXCD, off = wgid / NXCD; wgid = (xcd < r ? xcd * (q + 1) : r * (q + 1) + (xcd - r) * q) + off; }
        const int nig = WGM * nN, gid = wgid / nig, fm = gid * WGM, gsz = (nM - fm) < WGM ? (nM - fm) : WGM;
        u.pm = fm + ((wgid % nig) % gsz); u.pn = (wgid % nig) / gsz; u.ord = i; return true;
    }
    __device__ __forceinline__ void a_ready(const Unit&) const {}
    __device__ __forceinline__ void done(const Unit&) const {}
};

__device__ __forceinline__ unsigned cvt_pk_bf16(float lo, float hi) { unsigned r; asm volatile("v_cvt_pk_bf16_f32 %0, %1, %2" : "=v"(r) : "v"(lo), "v"(hi)); return r; }
typedef float f32x2 __attribute__((ext_vector_type(2)));
__device__ __forceinline__ f32x2 gelu_pk(f32x2 v) {
    const f32x2 av = __builtin_elementwise_abs(v), d = av * 0.2316418882f + 1.0f;
    f32x2 t; t.x = __builtin_amdgcn_rcpf(d.x); t.y = __builtin_amdgcn_rcpf(d.y);
    f32x2 q = t * 0.5307027145f + (-0.7265760135f); q = q * t + 0.7107068705f; q = q * t + (-0.142248368f); q = q * t + 0.127414796f; q = q * t;
    const f32x2 s = (v * v) * (-0.72134752044f);
    f32x2 e; e.x = __builtin_amdgcn_exp2f(s.x); e.y = __builtin_amdgcn_exp2f(s.y);
    const f32x2 m = v * (q * e), r = v - m;
    f32x2 o; o.x = v.x < 0.f ? m.x : r.x; o.y = v.y < 0.f ? m.y : r.y; return o;
}
typedef unsigned u32x2 __attribute__((ext_vector_type(2)));
__device__ __forceinline__ float sigmoid_f(float x) { return __builtin_amdgcn_rcpf(1.f + __builtin_amdgcn_exp2f(-1.4426950408889634f * x)); }
__device__ __forceinline__ float bf_lo(unsigned w) { return __uint_as_float(w << 16); }
__device__ __forceinline__ float bf_hi(unsigned w) { return __uint_as_float(w & 0xffff0000u); }
__device__ __forceinline__ float row_rstd(const float* SS, int row, int fq) {
    const f32x4 p = *(const f32x4*)(SS + (size_t)row * 16 + 4 * fq);
    float s = (p[0] + p[1]) + (p[2] + p[3]);
    s += __shfl_xor(s, 16); s += __shfl_xor(s, 32);
    return rsqrtf(s * (1.0f / 1024.0f) + 1e-6f);
}
__device__ __forceinline__ u32x4 pack8(const f32x4 a, const f32x4 b) { u32x4 w; w.x = cvt_pk_bf16(a[0], a[1]); w.y = cvt_pk_bf16(a[2], a[3]); w.z = cvt_pk_bf16(b[0], b[1]); w.w = cvt_pk_bf16(b[2], b[3]); return w; }
__device__ __forceinline__ f32x4 gelu4(const f32x4 v) { const f32x2 a = gelu_pk((f32x2){v[0], v[1]}), b = gelu_pk((f32x2){v[2], v[3]}); return (f32x4){a.x, a.y, b.x, b.y}; }
__device__ __forceinline__ float row_rstd(const float* SS, int row, int fq);
__device__ __forceinline__ float rstd_lds(const PG8_LAS float* tab, int nu, const float* SS, const Unit& u, int lrow, int row, int fq) { return u.ord < nu ? tab[u.ord * 256 + lrow] : row_rstd(SS, row, fq); }
constexpr float QSCALE = 0.125f * 1.4426950408889634f;

struct EpiIn {
    static constexpr bool PERM = true, AFTER_DRAIN = false;
    const float* SS; const float* cosT; const float* sinT;
    bf16_t *Q, *K, *VA, *U, *VB; unsigned char *GA8, *GB8; float* VST; const PG8_LAS float* rtab; int rnu;
    __device__ __forceinline__ void operator()(const f32x4 (&acc)[2][2][4][2], const Unit& u, int wr, int wc, int fr, int fq) const {
        const int row0 = u.pm * BM + wr * 64 + fr;
        const int sec = u.pn >> 2, pnl = u.pn & 3;
        const int col0 = pnl * BM + wc * 32 + 8 * fq;
        if (sec <= 1) {
            bf16_t* O = sec == 0 ? Q : K; const float sc = sec == 0 ? QSCALE : 1.0f;
            const int j0 = 4 * ((4 * wc + fq) & 7);
#pragma unroll
            for (int ai = 0; ai < 2; ++ai)
#pragma unroll
                for (int m = 0; m < 4; ++m) { const int row = row0 + ai * HALF + m * 16; const float rs = rstd_lds(rtab, rnu, SS, u, wr * 64 + fr + ai * HALF + m * 16, row, fq) * sc;
                    const int pos = row & 4095; const f32x4 c4 = *(const f32x4*)(cosT + pos * 32 + j0), s4 = *(const f32x4*)(sinT + pos * 32 + j0);
#pragma unroll
                    for (int bj = 0; bj < 2; ++bj) { const f32x4 x1 = acc[ai][bj][m][0] * rs, x2 = acc[ai][bj][m][1] * rs;
                        const f32x4 o1 = x1 * c4 - x2 * s4, o2 = x2 * c4 + x1 * s4;
                        *(u32x4*)(O + (size_t)row * 1024 + col0 + bj * HALF) = pack8(o1, o2); } }
        } else if (sec == 2) {
#pragma unroll
            for (int ai = 0; ai < 2; ++ai)
#pragma unroll
                for (int m = 0; m < 4; ++m) { const int row = row0 + ai * HALF + m * 16; const float rs = rstd_lds(rtab, rnu, SS, u, wr * 64 + fr + ai * HALF + m * 16, row, fq);
#pragma unroll
                    for (int bj = 0; bj < 2; ++bj) *(u32x4*)(VA + (size_t)row * 1024 + col0 + bj * HALF) = pack8(acc[ai][bj][m][0] * rs, acc[ai][bj][m][1] * rs); }
        } else if (sec == 3) {
#pragma unroll
            for (int ai = 0; ai < 2; ++ai)
#pragma unroll
                for (int m = 0; m < 4; ++m) { const int row = row0 + ai * HALF + m * 16; const float rs = rstd_lds(rtab, rnu, SS, u, wr * 64 + fr + ai * HALF + m * 16, row, fq);
#pragma unroll
                    for (int bj = 0; bj < 2; ++bj) *(u32x4*)(U + (size_t)row * 1024 + col0 + bj * HALF) = pack8(gelu4(acc[ai][bj][m][0] * rs), gelu4(acc[ai][bj][m][1] * rs)); }
        } else if (sec == 4) {
#pragma unroll
            for (int ai = 0; ai < 2; ++ai)
#pragma unroll
                for (int m = 0; m < 4; ++m) { const int row = row0 + ai * HALF + m * 16; const float rs = rstd_lds(rtab, rnu, SS, u, wr * 64 + fr + ai * HALF + m * 16, row, fq); float s1 = 0.f, s2 = 0.f;
#pragma unroll
                    for (int bj = 0; bj < 2; ++bj) { const f32x4 a = gelu4(acc[ai][bj][m][0] * rs), b = gelu4(acc[ai][bj][m][1] * rs);
                        s1 += ((a[0] + a[1]) + (a[2] + a[3])) + ((b[0] + b[1]) + (b[2] + b[3]));
                        s2 += ((a[0] * a[0] + a[1] * a[1]) + (a[2] * a[2] + a[3] * a[3])) + ((b[0] * b[0] + b[1] * b[1]) + (b[2] * b[2] + b[3] * b[3]));
                        *(u32x4*)(VB + (size_t)row * 1024 + col0 + bj * HALF) = pack8(a, b); }
                    s1 += __shfl_xor(s1, 16); s1 += __shfl_xor(s1, 32); s2 += __shfl_xor(s2, 16); s2 += __shfl_xor(s2, 32);
                    if (fq == 0) *(f32x2*)(VST + ((size_t)row * 16 + 4 * pnl + wc) * 2) = (f32x2){s1, s2}; }
        } else {
            unsigned char* G = sec == 5 ? GA8 : GB8;
#pragma unroll
            for (int ai = 0; ai < 2; ++ai)
#pragma unroll
                for (int m = 0; m < 4; ++m) { const int row = row0 + ai * HALF + m * 16; const float rs = rstd_lds(rtab, rnu, SS, u, wr * 64 + fr + ai * HALF + m * 16, row, fq);
#pragma unroll
                    for (int bj = 0; bj < 2; ++bj) { const f32x4 a = acc[ai][bj][m][0] * rs, b = acc[ai][bj][m][1] * rs; unsigned q[8];
#pragma unroll
                        for (int e = 0; e < 4; ++e) { q[e] = (unsigned)(sigmoid_f(a[e]) * 255.0f + 0.5f); q[4 + e] = (unsigned)(sigmoid_f(b[e]) * 255.0f + 0.5f); }
                        u32x2 w; w.x = q[0] | (q[1] << 8) | (q[2] << 16) | (q[3] << 24); w.y = q[4] | (q[5] << 8) | (q[6] << 16) | (q[7] << 24);
                        *(u32x2*)(G + (size_t)row * 1024 + col0 + bj * HALF) = w; } }
        }
    }
};
struct EpiProj {
    static constexpr bool PERM = true, AFTER_DRAIN = false;
    const unsigned char *GA8, *GB8; bf16_t* Y;
    __device__ __forceinline__ void operator()(const f32x4 (&acc)[2][2][4][2], const Unit& u, int wr, int wc, int fr, int fq) const {
        const int s = u.pm >> 7; const int row0 = (u.pm & 127) * BM + wr * 64 + fr; const int col0 = (u.pn & 3) * BM + wc * 32 + 8 * fq;
        const unsigned char* G = s ? GB8 : GA8; const float k = 1.0f / 255.0f;
#pragma unroll
        for (int ai = 0; ai < 2; ++ai) {
            u32x2 gq[4][2]; u32x4 yq[4][2];
#pragma unroll
            for (int m = 0; m < 4; ++m)
#pragma unroll
                for (int bj = 0; bj < 2; ++bj) { const size_t off = (size_t)(row0 + ai * HALF + m * 16) * 1024 + col0 + bj * HALF;
                    gq[m][bj] = *(const u32x2*)(G + off); if (s) yq[m][bj] = *(const u32x4*)(Y + off); }
#pragma unroll
            for (int m = 0; m < 4; ++m)
#pragma unroll
                for (int bj = 0; bj < 2; ++bj) { const size_t off = (size_t)(row0 + ai * HALF + m * 16) * 1024 + col0 + bj * HALF;
                    const u32x2 g = gq[m][bj];
                    f32x4 ga = (f32x4){(float)(g.x & 255u), (float)((g.x >> 8) & 255u), (float)((g.x >> 16) & 255u), (float)(g.x >> 24)} * k;
                    f32x4 gb = (f32x4){(float)(g.y & 255u), (float)((g.y >> 8) & 255u), (float)((g.y >> 16) & 255u), (float)(g.y >> 24)} * k;
                    f32x4 v0 = acc[ai][bj][m][0] * ga, v1 = acc[ai][bj][m][1] * gb;
                    if (s) { const u32x4 y = yq[m][bj];
                        v0 += (f32x4){bf_lo(y.x), bf_hi(y.x), bf_lo(y.y), bf_hi(y.y)}; v1 += (f32x4){bf_lo(y.z), bf_hi(y.z), bf_lo(y.w), bf_hi(y.w)}; }
                    *(u32x4*)(Y + off) = pack8(v0, v1); }
        }
    }
};
struct EpiRes {
    static constexpr bool PERM = true, AFTER_DRAIN = false;
    bf16_t* XB; float* SS;
    __device__ __forceinline__ void operator()(const f32x4 (&acc)[2][2][4][2], const Unit& u, int wr, int wc, int fr, int fq) const {
        const int row0 = u.pm * BM + wr * 64 + fr; const int col0 = u.pn * BM + wc * 32 + 8 * fq;
#pragma unroll
        for (int ai = 0; ai < 2; ++ai) {
            u32x4 xq[4][2];
#pragma unroll
            for (int m = 0; m < 4; ++m)
#pragma unroll
                for (int bj = 0; bj < 2; ++bj) xq[m][bj] = *(const u32x4*)(XB + (size_t)(row0 + ai * HALF + m * 16) * 1024 + col0 + bj * HALF);
#pragma unroll
            for (int m = 0; m < 4; ++m) { const int row = row0 + ai * HALF + m * 16; float q = 0.f;
#pragma unroll
                for (int bj = 0; bj < 2; ++bj) { const size_t off = (size_t)row * 1024 + col0 + bj * HALF;
                    const u32x4 xo = xq[m][bj];
                    const f32x4 v0 = acc[ai][bj][m][0] + (f32x4){bf_lo(xo.x), bf_hi(xo.x), bf_lo(xo.y), bf_hi(xo.y)}, v1 = acc[ai][bj][m][1] + (f32x4){bf_lo(xo.z), bf_hi(xo.z), bf_lo(xo.w), bf_hi(xo.w)};
                    *(u32x4*)(XB + off) = pack8(v0, v1);
                    q += ((v0[0] * v0[0] + v0[1] * v0[1]) + (v0[2] * v0[2] + v0[3] * v0[3])) + ((v1[0] * v1[0] + v1[1] * v1[1]) + (v1[2] * v1[2] + v1[3] * v1[3])); }
                q += __shfl_xor(q, 16); q += __shfl_xor(q, 32);
                if (fq == 0) SS[(size_t)row * 16 + 4 * u.pn + wc] = q; }
        }
    }
};
struct EpiGU {
    static constexpr bool PERM = true, AFTER_DRAIN = false;
    const float* SS; bf16_t* H; const PG8_LAS float* rtab; int rnu;
    __device__ __forceinline__ void operator()(const f32x4 (&acc)[2][2][4][2], const Unit& u, int wr, int wc, int fr, int fq) const {
        const int row0 = u.pm * BM + wr * 64 + fr; const int hc0 = u.pn * 128 + wc * 16 + 4 * fq;
#pragma unroll
        for (int ai = 0; ai < 2; ++ai)
#pragma unroll
            for (int m = 0; m < 4; ++m) { const int row = row0 + ai * HALF + m * 16; const float rs = rstd_lds(rtab, rnu, SS, u, wr * 64 + fr + ai * HALF + m * 16, row, fq);
#pragma unroll
                for (int bj = 0; bj < 2; ++bj) { const f32x4 g = acc[ai][bj][m][0] * rs, up = acc[ai][bj][m][1] * rs; f32x4 h;
#pragma unroll
                    for (int e = 0; e < 4; ++e) h[e] = g[e] * sigmoid_f(g[e]) * up[e];
                    u32x2 w; w.x = cvt_pk_bf16(h[0], h[1]); w.y = cvt_pk_bf16(h[2], h[3]);
                    *(u32x2*)(H + (size_t)row * 2816 + hc0 + bj * 64) = w; } }
    }
};
struct ProjOrder {
    StaticOrder b;
    __host__ __device__ void init(int M, int N, int G_, int c_) { b.init(M, N, G_, c_); }
    __host__ __device__ bool next(int i, Unit& u) const { Unit t; if (!b.next(i >> 1, t)) return false; u.pm = t.pm + 128 * (i & 1); u.pn = t.pn + 4 * (i & 1); return true; }
    __device__ __forceinline__ void a_ready(const Unit&) const {}
    __device__ __forceinline__ void done(const Unit&) const {}
};
template <class Epi, class Sched, bool ALIGN_EPI = false, bool SP2 = false>
__device__ __forceinline__ void gemm_phase(PG8_LAS unsigned char* lds, const Gemm g, const Sched& S, const Epi& E) {
    int tid_ = threadIdx.x; asm volatile("" : "+v"(tid_));
    const int tid = tid_, wid = __builtin_amdgcn_readfirstlane(tid >> 6), lane = tid & 63, wr = wid >> 2, wc = wid & 3, fr = lane & 15, fq = lane >> 4;
    const int K = g.K, nt = K / BK;
    unsigned voffA[2], voffB[2];
#pragma unroll
    for (int i = 0; i < 2; ++i) { int R, C; stage_rc(tid * 16 + i * 8192, R, C); const int Rb = Epi::PERM ? ((R & ~31) + perm32(R & 31)) : R;
        voffA[i] = (unsigned)(R * K + C) * 2u; voffB[i] = (unsigned)(Rb * K + C) * 2u; }
    const size_t kstep = (size_t)(BK * 2);
    const size_t hstep = (size_t)HALF * K * 2;
    const size_t tstep = 2 * hstep;
    const unsigned ldsw = (unsigned)wid * 1024u;
    const int aoff = lds_byte(wr * 64 + fr, fq * 8), boff = lds_byte(wc * 32 + fr, fq * 8);
#define PG8_SA(b, h) (((b) * 2 + (h)) * HTB)
#define PG8_SB(b, h) ((4 + (b) * 2 + (h)) * HTB)
#define PG8_STAGE(bufoff, gbase, voff) do { _Pragma("unroll") for (int _i = 0; _i < 2; ++_i) \
        __builtin_amdgcn_global_load_lds((const unsigned*)((const char*)(gbase) + (voff)[_i]), (PG8_LAS unsigned*)(lds + (bufoff) + ldsw + _i * 8192), 16, 0, 0); } while (0)
#define PG8_LDA(dst, b, h) do { _Pragma("unroll") for (int m = 0; m < 4; ++m) _Pragma("unroll") for (int k = 0; k < 2; ++k) dst[m][k] = *(const PG8_LAS bf16x8*)(lds + PG8_SA(b, h) + aoff + m * 2048 + k * 1024); } while (0)
#define PG8_LDB(dst, b, h) do { _Pragma("unroll") for (int n = 0; n < 2; ++n) _Pragma("unroll") for (int k = 0; k < 2; ++k) dst[n][k] = *(const PG8_LAS bf16x8*)(lds + PG8_SB(b, h) + boff + n * 2048 + k * 1024); } while (0)
#define PG8_MMA(ai, bj, At, Bt) do { __builtin_amdgcn_s_setprio(1); _Pragma("unroll") for (int m = 0; m < 4; ++m) _Pragma("unroll") for (int n = 0; n < 2; ++n) _Pragma("unroll") for (int k = 0; k < 2; ++k) \
        acc[ai][bj][m][n] = __builtin_amdgcn_mfma_f32_16x16x32_bf16(Bt[n][k], At[m][k], acc[ai][bj][m][n], 0, 0, 0); __builtin_amdgcn_s_setprio(0); } while (0)
#define PG8_WAIT_V(n) asm volatile("s_waitcnt vmcnt(" #n ")" ::: "memory")
#define PG8_WAIT_L(n) asm volatile("s_waitcnt lgkmcnt(" #n ")" ::: "memory")
#define PG8_BAR __builtin_amdgcn_s_barrier()
#define PG8_SCHED __builtin_amdgcn_sched_barrier(0)
    Unit cur, nxt; int ui = 0;
    if (!S.next(0, cur)) return;
    f32x4 acc[2][2][4][2];
#pragma unroll
    for (int a = 0; a < 2; ++a)
#pragma unroll
        for (int b = 0; b < 2; ++b)
#pragma unroll
            for (int m = 0; m < 4; ++m)
#pragma unroll
                for (int n = 0; n < 2; ++n) acc[a][b][m][n] = (f32x4){0.f, 0.f, 0.f, 0.f};
    bf16x8 At[4][2], B0[2][2], B1[2][2];
    const char* cA = (const char*)g.A + (size_t)cur.pm * tstep; const char* cB = (const char*)g.Bt + (size_t)cur.pn * tstep;
    S.a_ready(cur);
    if constexpr (SP2) {
        PG8_STAGE(PG8_SB(0, 0), cB, voffB); PG8_STAGE(PG8_SB(0, 1), cB + hstep, voffB); PG8_STAGE(PG8_SA(0, 0), cA, voffA); PG8_STAGE(PG8_SA(0, 1), cA + hstep, voffA);
        if (wr == 1) PG8_BAR;
        PG8_WAIT_V(2); PG8_BAR;
        PG8_STAGE(PG8_SB(1, 0), cB + kstep, voffB); PG8_STAGE(PG8_SA(1, 0), cA + kstep, voffA); PG8_STAGE(PG8_SB(1, 1), cB + hstep + kstep, voffB);
        PG8_WAIT_V(6); PG8_BAR;
    } else {
        PG8_STAGE(PG8_SB(0, 0), cB, voffB); PG8_STAGE(PG8_SA(0, 0), cA, voffA); PG8_STAGE(PG8_SB(0, 1), cB + hstep, voffB); PG8_STAGE(PG8_SA(0, 1), cA + hstep, voffA);
        if (wr == 1) PG8_BAR;
        PG8_WAIT_V(4); PG8_BAR;
        PG8_STAGE(PG8_SB(1, 0), cB + kstep, voffB); PG8_STAGE(PG8_SA(1, 0), cA + kstep, voffA); PG8_STAGE(PG8_SB(1, 1), cB + hstep + kstep, voffB);
        PG8_WAIT_V(6); PG8_BAR;
    }
    for (;;) {
        const bool has_next = S.next(ui + 1, nxt);
        const char* nA = has_next ? (const char*)g.A + (size_t)nxt.pm * tstep : cA; const char* nB = has_next ? (const char*)g.Bt + (size_t)nxt.pn * tstep : cB;
        for (int t = 0; t < nt; t += 2) {
            const bool last = (t == nt - 2);
            const char* a1 = cA + (size_t)(t + 1) * kstep;
            const char* a2 = last ? nA : cA + (size_t)(t + 2) * kstep; const char* b2 = last ? nB : cB + (size_t)(t + 2) * kstep;
            const char* a3 = a2 + kstep; const char* b3 = b2 + kstep;
            if (last && has_next) S.a_ready(nxt);
            if constexpr (SP2) {
            PG8_LDB(B0, 0, 0); PG8_LDB(B1, 0, 1); PG8_SCHED; PG8_LDA(At, 0, 0); PG8_STAGE(PG8_SA(1, 1), a1 + hstep, voffA);
            PG8_WAIT_V(8); PG8_WAIT_L(0); PG8_BAR; PG8_MMA(0, 0, At, B0); PG8_MMA(0, 1, At, B1); PG8_BAR; PG8_SCHED;
            PG8_LDA(At, 0, 1); PG8_STAGE(PG8_SB(0, 0), b2, voffB); PG8_STAGE(PG8_SB(0, 1), b2 + hstep, voffB); PG8_STAGE(PG8_SA(0, 0), a2, voffA);
            PG8_WAIT_V(8); PG8_WAIT_L(0); PG8_BAR; PG8_MMA(1, 0, At, B0); PG8_MMA(1, 1, At, B1); PG8_BAR; PG8_SCHED;
            PG8_LDB(B0, 1, 0); PG8_LDB(B1, 1, 1); PG8_SCHED; PG8_LDA(At, 1, 0); PG8_STAGE(PG8_SA(0, 1), a2 + hstep, voffA);
            PG8_WAIT_V(8); PG8_WAIT_L(0); PG8_BAR; PG8_MMA(0, 0, At, B0); PG8_MMA(0, 1, At, B1); PG8_BAR; PG8_SCHED;
            PG8_LDA(At, 1, 1); PG8_STAGE(PG8_SB(1, 0), b3, voffB); PG8_STAGE(PG8_SB(1, 1), b3 + hstep, voffB); PG8_STAGE(PG8_SA(1, 0), a3, voffA);
            PG8_WAIT_V(8); PG8_WAIT_L(0); PG8_BAR; PG8_MMA(1, 0, At, B0); PG8_MMA(1, 1, At, B1); PG8_BAR; PG8_SCHED;
            } else {
            PG8_LDB(B0, 0, 0); PG8_SCHED; PG8_LDA(At, 0, 0); PG8_STAGE(PG8_SA(1, 1), a1 + hstep, voffA);
            PG8_WAIT_L(8); PG8_BAR; PG8_WAIT_L(0); PG8_MMA(0, 0, At, B0); PG8_BAR; PG8_SCHED;
            PG8_LDB(B1, 0, 1); PG8_STAGE(PG8_SB(0, 0), b2, voffB);
            PG8_BAR; PG8_WAIT_L(0); PG8_MMA(0, 1, At, B1); PG8_BAR;
            PG8_LDA(At, 0, 1); PG8_STAGE(PG8_SA(0, 0), a2, voffA);
            PG8_BAR; PG8_WAIT_L(0); PG8_MMA(1, 0, At, B0); PG8_BAR; PG8_SCHED;
            PG8_STAGE(PG8_SB(0, 1), b2 + hstep, voffB);
            PG8_WAIT_V(6); PG8_BAR; PG8_MMA(1, 1, At, B1); PG8_BAR;
            PG8_LDB(B0, 1, 0); PG8_SCHED; PG8_LDA(At, 1, 0); PG8_STAGE(PG8_SA(0, 1), a2 + hstep, voffA);
            PG8_WAIT_L(8); PG8_BAR; PG8_WAIT_L(0); PG8_MMA(0, 0, At, B0); PG8_BAR; PG8_SCHED;
            PG8_LDB(B1, 1, 1); PG8_STAGE(PG8_SB(1, 0), b3, voffB);
            PG8_BAR; PG8_WAIT_L(0); PG8_MMA(0, 1, At, B1); PG8_BAR;
            PG8_LDA(At, 1, 1); PG8_STAGE(PG8_SA(1, 0), a3, voffA);
            PG8_BAR; PG8_WAIT_L(0); PG8_MMA(1, 0, At, B0); PG8_BAR; PG8_SCHED;
            PG8_STAGE(PG8_SB(1, 1), b3 + hstep, voffB);
            PG8_WAIT_V(6); PG8_BAR; PG8_MMA(1, 1, At, B1); PG8_BAR;
            }
        }
        if constexpr (ALIGN_EPI) { if (wr == 0) PG8_BAR; }
        if constexpr (!Epi::AFTER_DRAIN) { E(acc, cur, wr, wc, fr, fq); S.done(cur); }
        if (!has_next) break;
#pragma unroll
        for (int a = 0; a < 2; ++a)
#pragma unroll
            for (int b = 0; b < 2; ++b)
#pragma unroll
                for (int m = 0; m < 4; ++m)
#pragma unroll
                    for (int n = 0; n < 2; ++n) acc[a][b][m][n] = (f32x4){0.f, 0.f, 0.f, 0.f};
        cur = nxt; cA = nA; cB = nB; ++ui;
        if constexpr (ALIGN_EPI) { if (wr == 1) PG8_BAR; }
    }
    PG8_WAIT_V(0);
    if constexpr (!ALIGN_EPI) { if (wr == 0) PG8_BAR; }
    PG8_BAR;
    if constexpr (Epi::AFTER_DRAIN) { E.fused(acc, cur, wr, wc, fr, fq, lds, wid, lane); S.done(cur); }
#undef PG8_SA
#undef PG8_SB
#undef PG8_STAGE
#undef PG8_LDA
#undef PG8_LDB
#undef PG8_MMA
#undef PG8_WAIT_V
#undef PG8_WAIT_L
#undef PG8_BAR
#undef PG8_SCHED
}
}

constexpr int BATCH = 8, SEQ = 4096, DM = 1024, DEPTH = 4, T = BATCH * SEQ, NIN = 7168, DFF = 2816, NGU = 2 * DFF;
constexpr int NWAVES = 8, NTHR = 512;
#define LAS __attribute__((address_space(3)))
typedef unsigned short bf16;
typedef short bf16x8 __attribute__((ext_vector_type(8)));
typedef short s16x4 __attribute__((ext_vector_type(4)));
typedef float f32x4 __attribute__((ext_vector_type(4)));
typedef float f32x2 __attribute__((ext_vector_type(2)));
typedef float f32x16 __attribute__((ext_vector_type(16)));
typedef unsigned u32x4 __attribute__((ext_vector_type(4)));
typedef unsigned u32x2 __attribute__((ext_vector_type(2)));
constexpr size_t MiB = 1u << 20;
constexpr size_t WS_COS = 1 * MiB, WS_SIN = WS_COS + MiB / 2, WS_WSP = 2 * MiB, WS_SS = 3 * MiB, WS_VST = 5 * MiB;
constexpr size_t WS_WIN = 10 * MiB, WS_WPAB = 24 * MiB, WS_WOUT = 28 * MiB, WS_WGU = 30 * MiB, WS_WD = 41 * MiB;
constexpr size_t WS_XB = 48 * MiB, WS_Q = 112 * MiB, WS_U = 176 * MiB, WS_K = 240 * MiB, WS_VA = 304 * MiB, WS_VB = 368 * MiB, WS_GA = 432 * MiB, WS_GB = 464 * MiB, WS_END = 496 * MiB;
constexpr size_t WS_Y = WS_K, WS_H = WS_K;
static_assert(WS_U == WS_Q + (size_t)T * DM * 2 && WS_H + (size_t)T * DFF * 2 <= WS_GA, "ws map");
constexpr int LDS_BYTES = 147456, LDS_XB = 147456 - 64;
constexpr size_t WS_CTL = 0, CTL_ZERO_BYTES = 16384;

__device__ __forceinline__ unsigned f2bf(float f) { unsigned u = __builtin_bit_cast(unsigned, f); return (u + 0x7fffu + ((u >> 16) & 1u)) >> 16; }
__device__ __forceinline__ unsigned pk2(float lo, float hi) { return f2bf(lo) | (f2bf(hi) << 16); }
__device__ __forceinline__ float bflo(unsigned w) { return __uint_as_float(w << 16); }
__device__ __forceinline__ float bfhi(unsigned w) { return __uint_as_float(w & 0xffff0000u); }
__device__ __forceinline__ float wave_sum(float v) {
#pragma unroll
    for (int o = 1; o < 64; o <<= 1) v += __shfl_xor(v, o);
    return v;
}
struct Params {
    const float* in[20]; float* out; unsigned char* ws; int ph_lo, ph_hi;
};
typedef const __attribute__((address_space(4))) Params* PP;
struct MapId { __device__ __forceinline__ int operator()(int n) const { return n; } };
struct MapIn {
    __device__ __forceinline__ int operator()(int n) const { if (n >= 2048) return n; const int j = n & 63, jj = j & 31; return (n & ~63) + 8 * (jj >> 2) + (jj & 3) + ((j >> 5) << 2); } };
struct MapGU { int up;
    __device__ __forceinline__ int operator()(int hd) const { const int r = hd & 127; return 256 * (hd >> 7) + 8 * (r >> 2) + 4 * up + (r & 3); } };
template <class Map>
__device__ __forceinline__ void transpose_item(const float* W, int K, int N, bf16* WT, const float* gk, const Map& mp, LAS float* scr, int item, int lane) {
    const int nblk = N / 32, kb = item / nblk, nb = item % nblk, k0 = 64 * kb, n0 = 32 * nb;
#pragma unroll 8
    for (int i = 0; i < 32; ++i) { const int kk = 2 * i + (lane >> 5); scr[kk * 33 + (lane & 31)] = W[(size_t)(k0 + kk) * N + n0 + (lane & 31)]; }
    asm volatile("s_waitcnt lgkmcnt(0)" ::: "memory");
    const int c = lane & 7; float gs[8];
#pragma unroll
    for (int e = 0; e < 8; ++e) gs[e] = gk ? gk[k0 + 8 * c + e] : 1.0f;
#pragma unroll
    for (int j = 0; j < 4; ++j) { const int n = (lane >> 3) + 8 * j; const LAS float* s = scr + (8 * c) * 33 + n;
        u32x4 o; o.x = pk2(s[0 * 33] * gs[0], s[1 * 33] * gs[1]); o.y = pk2(s[2 * 33] * gs[2], s[3 * 33] * gs[3]); o.z = pk2(s[4 * 33] * gs[4], s[5 * 33] * gs[5]); o.w = pk2(s[6 * 33] * gs[6], s[7 * 33] * gs[7]);
        *(u32x4*)(WT + (size_t)mp(n0 + n) * K + k0 + 8 * c) = o; }
    asm volatile("s_waitcnt lgkmcnt(0)" ::: "memory");
}
struct CvItem { const float* W; bf16* WT; const float* gk; int K, N, mk, item; };
__device__ __forceinline__ int cv_map(int mk, int n) { return mk == 0 ? n : mk == 1 ? MapIn{}(n) : MapGU{mk - 2}(n); }
__device__ __forceinline__ void cv_load(const CvItem& d, int lane, float (&wv)[32]) {
    const int nblk = d.N / 32, kb = d.item / nblk, nb = d.item % nblk, k0 = 64 * kb, n0 = 32 * nb;
#pragma unroll
    for (int i = 0; i < 32; ++i) wv[i] = d.W[(size_t)(k0 + 2 * i + (lane >> 5)) * d.N + n0 + (lane & 31)];
}
__device__ __forceinline__ void cv_store(const CvItem& d, LAS float* scr, int lane, const float (&wv)[32]) {
    const int nblk = d.N / 32, kb = d.item / nblk, nb = d.item % nblk, k0 = 64 * kb, n0 = 32 * nb;
#pragma unroll
    for (int i = 0; i < 32; ++i) scr[(2 * i + (lane >> 5)) * 33 + (lane & 31)] = wv[i];
    asm volatile("s_waitcnt lgkmcnt(0)" ::: "memory");
    const int c = lane & 7; float gs[8];
#pragma unroll
    for (int e = 0; e < 8; ++e) gs[e] = d.gk ? d.gk[k0 + 8 * c + e] : 1.0f;
#pragma unroll
    for (int j = 0; j < 4; ++j) { const int n = (lane >> 3) + 8 * j; const LAS float* s = scr + (8 * c) * 33 + n;
        u32x4 o; o.x = pk2(s[0 * 33] * gs[0], s[1 * 33] * gs[1]); o.y = pk2(s[2 * 33] * gs[2], s[3 * 33] * gs[3]); o.z = pk2(s[4 * 33] * gs[4], s[5 * 33] * gs[5]); o.w = pk2(s[6 * 33] * gs[6], s[7 * 33] * gs[7]);
        *(u32x4*)(d.WT + (size_t)cv_map(d.mk, n0 + n) * d.K + k0 + 8 * c) = o; }
    asm volatile("s_waitcnt lgkmcnt(0)" ::: "memory");
}
constexpr int I_IN = (DM / 64) * (NIN / 32), I_P = (DM / 64) * (DM / 32), NITEMS_A = I_IN + 3 * I_P;
constexpr int I_G = (DM / 64) * (DFF / 32), I_D = (DFF / 64) * (DM / 32), NITEMS_B = 2 * I_G + I_D;
__device__ __forceinline__ CvItem decode_A(PP p, int l, int it) {
    int r = it;
    if (r < I_IN) return CvItem{p->in[2] + (size_t)l * DM * NIN, (bf16*)(p->ws + WS_WIN), p->in[1] + (size_t)l * DM, DM, NIN, 1, r}; r -= I_IN;
    if (r < I_P) return CvItem{p->in[12] + (size_t)l * DM * DM, (bf16*)(p->ws + WS_WPAB), nullptr, DM, DM, 0, r}; r -= I_P;
    if (r < I_P) return CvItem{p->in[13] + (size_t)l * DM * DM, (bf16*)(p->ws + WS_WPAB) + (size_t)DM * DM, nullptr, DM, DM, 0, r}; r -= I_P;
    return CvItem{p->in[14] + (size_t)l * DM * DM, (bf16*)(p->ws + WS_WOUT), nullptr, DM, DM, 0, r};
}
__device__ __forceinline__ CvItem decode_B(PP p, int l, int it) {
    int r = it; const float* g = p->in[15] + (size_t)l * DM;
    if (r < I_G) return CvItem{p->in[16] + (size_t)l * DM * DFF, (bf16*)(p->ws + WS_WGU), g, DM, DFF, 2, r}; r -= I_G;
    if (r < I_G) return CvItem{p->in[17] + (size_t)l * DM * DFF, (bf16*)(p->ws + WS_WGU), g, DM, DFF, 3, r}; r -= I_G;
    return CvItem{p->in[18] + (size_t)l * DFF * DM, (bf16*)(p->ws + WS_WD), nullptr, DFF, DM, 0, r};
}
template <bool IS_A>
__device__ __forceinline__ void convert_AB(PP p, int l, LAS unsigned char* lds, int gw, int NGW, int wave, int lane) {
    LAS float* scr = (LAS float*)(lds + wave * 8704); constexpr int N = IS_A ? NITEMS_A : NITEMS_B;
    for (int base = gw; base < N; base += 3 * NGW) {
        CvItem d0 = IS_A ? decode_A(p, l, base) : decode_B(p, l, base), d1 = d0, d2 = d0; float w0[32], w1[32], w2[32];
        const bool ok1 = base + NGW < N, ok2 = base + 2 * NGW < N;
        cv_load(d0, lane, w0);
        if (ok1) { d1 = IS_A ? decode_A(p, l, base + NGW) : decode_B(p, l, base + NGW); cv_load(d1, lane, w1); }
        if (ok2) { d2 = IS_A ? decode_A(p, l, base + 2 * NGW) : decode_B(p, l, base + 2 * NGW); cv_load(d2, lane, w2); }
        cv_store(d0, scr, lane, w0);
        if (ok1) cv_store(d1, scr, lane, w1);
        if (ok2) cv_store(d2, scr, lane, w2);
    }
}
__device__ __forceinline__ void convert_A(PP p, int l, LAS unsigned char* lds, int gw, int NGW, int wave, int lane) { convert_AB<true>(p, l, lds, gw, NGW, wave, lane); }
__device__ __forceinline__ void convert_B(PP p, int l, LAS unsigned char* lds, int gw, int NGW, int wave, int lane) { convert_AB<false>(p, l, lds, gw, NGW, wave, lane); }
__device__ __forceinline__ void prologue(PP p, LAS unsigned char* lds, int gw, int NGW, int wave, int lane) {
    convert_A(p, 0, lds, gw, NGW, wave, lane);
    convert_B(p, 0, lds, gw, NGW, wave, lane);
    const int gt = gw * 64 + lane, NGT = NGW * 64;
    float* cosT = (float*)(p->ws + WS_COS); float* sinT = (float*)(p->ws + WS_SIN);
    for (int i = gt; i < SEQ * 32; i += NGT) { const int pos = i >> 5, j = i & 31;
        const float inv = exp2f(-(float)j * (13.287712379549449f / 32.0f));
        const float ang = (float)pos * inv;
        const double rev = (double)ang * 0.15915494309189535; const double fr = rev - floor(rev + 0.5);
        const float rad = (float)(fr * 6.283185307179586);
        cosT[i] = cosf(rad); sinT[i] = sinf(rad); }
    bf16* wsp = (bf16*)(p->ws + WS_WSP);
    for (int i = gt; i < DEPTH * 8 * 128 * 128; i += NGT) { const int s = i & 127, t = (i >> 7) & 127; const float w = p->in[10][i]; wsp[i] = (bf16)f2bf((t < 64 && s >= 64) ? 0.f : w); }
    const float* x = p->in[0]; bf16* XB = (bf16*)(p->ws + WS_XB); float* SS = (float*)(p->ws + WS_SS);
    for (int m = gw; m < T; m += NGW) {
        const f32x4* xr = (const f32x4*)(x + (size_t)m * DM) + lane; float s = 0.f;
        unsigned long long* o8 = (unsigned long long*)(XB + (size_t)m * DM) + lane;
#pragma unroll
        for (int j = 0; j < 4; ++j) { const f32x4 v = xr[64 * j]; s += (v[0] * v[0] + v[1] * v[1]) + (v[2] * v[2] + v[3] * v[3]);
            o8[64 * j] = (unsigned long long)pk2(v[0], v[1]) | ((unsigned long long)pk2(v[2], v[3]) << 32); }
        s = wave_sum(s);
        if (lane < 16) SS[(size_t)m * 16 + lane] = lane == 0 ? s : 0.f;
    }
}
__device__ __forceinline__ void final_norm(PP p, int gw, int NGW, int lane) {
    const float* g = p->in[19]; const bf16* XB = (const bf16*)(p->ws + WS_XB);
    for (int m = gw; m < T; m += NGW) {
        const u32x4* xr = (const u32x4*)(XB + (size_t)m * DM) + lane; f32x4* orow = (f32x4*)(p->out + (size_t)m * DM); float v[2][8]; float s = 0.f;
#pragma unroll
        for (int j = 0; j < 2; ++j) { const u32x4 w = xr[64 * j]; v[j][0] = bflo(w.x); v[j][1] = bfhi(w.x); v[j][2] = bflo(w.y); v[j][3] = bfhi(w.y); v[j][4] = bflo(w.z); v[j][5] = bfhi(w.z); v[j][6] = bflo(w.w); v[j][7] = bfhi(w.w);
#pragma unroll
            for (int e = 0; e < 8; ++e) s += v[j][e] * v[j][e]; }
        const float rs = rsqrtf(wave_sum(s) * (1.0f / DM) + 1e-6f);
#pragma unroll
        for (int j = 0; j < 2; ++j) { const int c = (lane + 64 * j) * 8; const f32x4 g0 = *(const f32x4*)(g + c), g1 = *(const f32x4*)(g + c + 4);
            orow[(c >> 2)] = (f32x4){v[j][0], v[j][1], v[j][2], v[j][3]} * rs * g0; orow[(c >> 2) + 1] = (f32x4){v[j][4], v[j][5], v[j][6], v[j][7]} * rs * g1; }
    }
}
#ifndef FORCE_BAD_EXPR
#define FORCE_BAD_EXPR
#endif
namespace att {
constexpr int KSTR = 144, VSTR = 320, KB = 2 * 64 * KSTR, VB_ = 64 * VSTR;
constexpr int OFF_K = 0, OFF_V = 2 * KB, OFF_WSF = OFF_V + 3 * VB_, OFF_END = OFF_WSF + NWAVES * 256;
static_assert(OFF_END <= 131072 && 65536 <= OFF_WSF, "attention LDS map");
__device__ __forceinline__ int crow(int r, int hi) { return (r & 3) + 8 * (r >> 2) + 4 * hi; }
typedef __bf16 bf16x2_t __attribute__((ext_vector_type(2)));
__device__ __forceinline__ unsigned cvtpk(float lo, float hi) { const f32x2 v = {lo, hi}; const bf16x2_t b = __builtin_convertvector(v, bf16x2_t); return __builtin_bit_cast(unsigned, b); }
__device__ __forceinline__ void qk_softmax(const LAS unsigned char* kst, const bf16x8 (&qr)[4], f32x16& negm, float& lsum, u32x4 (&pw)[4], bool first) {
    f32x16 p0, p1;
#pragma unroll
    for (int d0 = 0; d0 < 4; ++d0) {
        const bf16x8 k0 = *(const LAS bf16x8*)(kst + d0 * 32), k1 = *(const LAS bf16x8*)(kst + 32 * KSTR + d0 * 32);
        if (d0 == 0) { p0 = __builtin_amdgcn_mfma_f32_32x32x16_bf16(k0, qr[0], negm, 0, 0, 0); p1 = __builtin_amdgcn_mfma_f32_32x32x16_bf16(k1, qr[0], negm, 0, 0, 0); }
        else { p0 = __builtin_amdgcn_mfma_f32_32x32x16_bf16(k0, qr[d0], p0, 0, 0, 0); p1 = __builtin_amdgcn_mfma_f32_32x32x16_bf16(k1, qr[d0], p1, 0, 0, 0); }
    }
    if (first) {
        float rm = __builtin_fmaxf(__builtin_fmaxf(p0[0], p1[0]), p0[1]);
#pragma unroll
        for (int r = 1; r < 15; ++r) rm = __builtin_fmaxf(__builtin_fmaxf(rm, p1[r]), p0[r + 1]);
        rm = __builtin_fmaxf(rm, p1[15]);
        { auto rr = __builtin_amdgcn_permlane32_swap(__float_as_uint(rm), __float_as_uint(rm), false, false); rm = __builtin_fmaxf(__uint_as_float(rr[0]), __uint_as_float(rr[1])); }
        rm += 40.0f;
#pragma unroll
        for (int r = 0; r < 16; ++r) { p0[r] -= rm; p1[r] -= rm; negm[r] = -rm; }
    }
    float ps = 0.f;
#pragma unroll
    for (int r = 0; r < 16; ++r) { p0[r] = __builtin_amdgcn_exp2f(p0[r]); p1[r] = __builtin_amdgcn_exp2f(p1[r]); ps += p0[r] + p1[r]; }
    lsum += ps;
#pragma unroll
    for (int e = 0; e < 4; ++e) { pw[0][e] = cvtpk(p0[2 * e], p0[2 * e + 1]); pw[1][e] = cvtpk(p0[8 + 2 * e], p0[8 + 2 * e + 1]); pw[2][e] = cvtpk(p1[2 * e], p1[2 * e + 1]); pw[3][e] = cvtpk(p1[8 + 2 * e], p1[8 + 2 * e + 1]); }
}
__device__ __forceinline__ void qk_softmax_safe(const LAS unsigned char* kst, const bf16x8 (&qr)[4], f32x16 (&o)[4], float& mhat, float& lsum, u32x4 (&pw)[4], LAS float* wsf, int r32, int hi, bool first) {
    f32x16 p0, p1;
#pragma unroll
    for (int r = 0; r < 16; ++r) { p0[r] = 0.f; p1[r] = 0.f; }
#pragma unroll
    for (int d0 = 0; d0 < 4; ++d0) {
        const bf16x8 k0 = *(const LAS bf16x8*)(kst + d0 * 32), k1 = *(const LAS bf16x8*)(kst + 32 * KSTR + d0 * 32);
        p0 = __builtin_amdgcn_mfma_f32_32x32x16_bf16(k0, qr[d0], p0, 0, 0, 0);
        p1 = __builtin_amdgcn_mfma_f32_32x32x16_bf16(k1, qr[d0], p1, 0, 0, 0);
    }
#pragma unroll
    for (int r = 0; r < 16; ++r) { p0[r] -= mhat; p1[r] -= mhat; }
    float rm = __builtin_fmaxf(__builtin_fmaxf(p0[0], p1[0]), p0[1]);
    rm = __builtin_fmaxf(__builtin_fmaxf(rm, p1[1]), p0[2]);
#pragma unroll
    for (int r = 2; r < 16; r += 2) { rm = __builtin_fmaxf(__builtin_fmaxf(rm, p1[r]), p0[r + 1]); if (r + 2 < 16) rm = __builtin_fmaxf(__builtin_fmaxf(rm, p1[r + 1]), p0[r + 2]); else rm = __builtin_fmaxf(rm, p1[r + 1]); }
    { auto rr = __builtin_amdgcn_permlane32_swap(__float_as_uint(rm), __float_as_uint(rm), false, false); rm = __builtin_fmaxf(__uint_as_float(rr[0]), __uint_as_float(rr[1])); }
    if (first || __any(rm > 8.0f)) {
        const float dl = first ? rm : __builtin_fmaxf(rm, 0.f), f = first ? 0.f : __builtin_amdgcn_exp2f(-dl); mhat += dl; lsum *= f;
#pragma unroll
        for (int r = 0; r < 16; ++r) { p0[r] -= dl; p1[r] -= dl; }
        if (hi == 0) wsf[r32] = f;
        asm volatile("s_waitcnt lgkmcnt(0)" ::: "memory");
#pragma unroll
        for (int r = 0; r < 16; ++r) { const float fr_ = wsf[crow(r, hi)];
#pragma unroll
            for (int d = 0; d < 4; ++d) o[d][r] *= fr_; }
        asm volatile("s_waitcnt lgkmcnt(0)" ::: "memory");
    }
    float ps = 0.f;
#pragma unroll
    for (int r = 0; r < 16; ++r) { p0[r] = __builtin_amdgcn_exp2f(p0[r]); p1[r] = __builtin_amdgcn_exp2f(p1[r]); ps += p0[r] + p1[r]; }
    lsum += ps;
#pragma unroll
    for (int e = 0; e < 4; ++e) { pw[0][e] = cvtpk(p0[2 * e], p0[2 * e + 1]); pw[1][e] = cvtpk(p0[8 + 2 * e], p0[8 + 2 * e + 1]); pw[2][e] = cvtpk(p1[2 * e], p1[2 * e + 1]); pw[3][e] = cvtpk(p1[8 + 2 * e], p1[8 + 2 * e + 1]); }
}
#define ATT_VRD(buf, ks) do { _Pragma("unroll") for (int d = 0; d < 4; ++d) { \
        lo[buf][d] = __builtin_bit_cast(s16x4, __builtin_amdgcn_ds_read_tr16_b64_v4i16((LAS s16x4*)(vb + (ks) * 16 * VSTR + d * 64))); \
        up[buf][d] = __builtin_bit_cast(s16x4, __builtin_amdgcn_ds_read_tr16_b64_v4i16((LAS s16x4*)(vb + (ks) * 16 * VSTR + 8 * VSTR + d * 64))); } } while (0)
#define ATT_VMM(buf, ks) do { _Pragma("unroll") for (int d = 0; d < 4; ++d) { \
        const bf16x8 vf = (bf16x8){lo[buf][d][0], lo[buf][d][1], lo[buf][d][2], lo[buf][d][3], up[buf][d][0], up[buf][d][1], up[buf][d][2], up[buf][d][3]}; \
        o[d] = __builtin_amdgcn_mfma_f32_32x32x16_bf16(__builtin_bit_cast(bf16x8, pw[ks]), vf, o[d], 0, 0, 0); } } while (0)
__device__ __forceinline__ void pv_tile(const LAS unsigned char* vb, const u32x4 (&pw)[4], f32x16 (&o)[4]) {
    s16x4 lo[2][4], up[2][4];
    __builtin_amdgcn_sched_barrier(0);
    ATT_VRD(0, 0); __builtin_amdgcn_sched_barrier(0);
    ATT_VRD(1, 1); __builtin_amdgcn_sched_barrier(0);
    ATT_VMM(0, 0); __builtin_amdgcn_sched_barrier(0);
    ATT_VRD(0, 2); __builtin_amdgcn_sched_barrier(0);
    ATT_VMM(1, 1); __builtin_amdgcn_sched_barrier(0);
    ATT_VRD(1, 3); __builtin_amdgcn_sched_barrier(0);
    ATT_VMM(0, 2); __builtin_amdgcn_sched_barrier(0);
    ATT_VMM(1, 3); __builtin_amdgcn_sched_barrier(0);
}
#undef ATT_VRD
#undef ATT_VMM
template <bool SAFE>
__device__ __forceinline__ bool attn_unit(int b, int h, int qb, int qb_next, u32x4& sk0, u32x4& sk1, u32x4& sv0, u32x4& sv1, bf16x8 (&qr)[4], bf16* QO, const bf16* __restrict__ Kg, const bf16* __restrict__ Vg, float lam, float oscale, const float* __restrict__ subg, LAS unsigned char* lds, bool dry = false) {
    int tid_ = threadIdx.x; asm volatile("" : "+v"(tid_));
    const int tid = tid_, lane = tid & 63, r32 = lane & 31, hi = lane >> 5; const int w = __builtin_amdgcn_readfirstlane(tid >> 6), mi = w >> 2, rb = w & 3;
    const size_t rowbase = (size_t)b * SEQ; const int q0 = qb * 128;
    const int NT = 2 * qb + 2, ntw = 2 * qb + 1 + (rb >> 1);
    const int skey = tid >> 4, sch = tid & 15;
    const bf16* kgp = Kg + (rowbase + skey) * DM + h * 128 + sch * 8; const bf16* vgp = Vg + (rowbase + skey) * DM + h * 128 + sch * 8;
    const int kls = OFF_K + (sch >> 3) * (64 * KSTR) + skey * KSTR + (sch & 7) * 16, vls = OFF_V + skey * VSTR + sch * 16;
#define LOADT(t) do { const size_t o_ = (size_t)(t) * 64 * DM; sk0 = *(const u32x4*)(kgp + o_); sk1 = *(const u32x4*)(kgp + o_ + 32 * DM); sv0 = *(const u32x4*)(vgp + o_); sv1 = *(const u32x4*)(vgp + o_ + 32 * DM); } while (0)
#define STORET(kb, vb3) do { *(LAS u32x4*)(lds + (kb) * KB + kls) = sk0; *(LAS u32x4*)(lds + (kb) * KB + kls + 32 * KSTR) = sk1; *(LAS u32x4*)(lds + (vb3) + vls) = sv0; *(LAS u32x4*)(lds + (vb3) + vls + 32 * VSTR) = sv1; } while (0)
    if (SAFE) {
        LOADT(0);
        const bf16* qp = QO + (rowbase + q0 + rb * 32 + r32) * DM + h * 128 + mi * 64 + hi * 8;
#pragma unroll
        for (int d0 = 0; d0 < 4; ++d0) qr[d0] = *(const bf16x8*)(qp + d0 * 16);
    }
    STORET(0, 0);
    __syncthreads();
    f32x16 o[4];
#pragma unroll
    for (int d = 0; d < 4; ++d)
#pragma unroll
        for (int r = 0; r < 16; ++r) o[d][r] = 0.f;
    float lsum = 0.f, mhat = 0.f; f32x16 negm;
#pragma unroll
    for (int r = 0; r < 16; ++r) negm[r] = 0.f;
    u32x4 pw[4];
#pragma unroll
    for (int i = 0; i < 4; ++i) pw[i] = (u32x4){0u, 0u, 0u, 0u};
    LAS float* wsf = (LAS float*)(lds + OFF_WSF + w * 256);
    const unsigned kfo = OFF_K + mi * (64 * KSTR) + r32 * KSTR + hi * 16;
    const unsigned vfo = OFF_V + (4 * hi + ((lane & 15) >> 2)) * VSTR + (((lane >> 4) & 1) * 16 + (lane & 3) * 4) * 2;
    int vcur = 0, vprev = 2 * VB_, vnext = VB_;
    for (int t = 0; t < NT; ++t) {
        if (t + 1 < NT) LOADT(t + 1);
        if (mi == 1 && t >= 1 && t - 1 < ntw) pv_tile(lds + vprev + vfo, pw, o);
        if (t < ntw) { if (SAFE) qk_softmax_safe(lds + (t & 1) * KB + kfo, qr, o, mhat, lsum, pw, wsf, r32, hi, t == 0); else qk_softmax(lds + (t & 1) * KB + kfo, qr, negm, lsum, pw, t == 0); }
        if (mi == 0 && t < ntw) pv_tile(lds + vcur + vfo, pw, o);
        if (t + 1 < NT) STORET((t + 1) & 1, vnext);
        __syncthreads();
        { const int tmp = vprev; vprev = vcur; vcur = vnext; vnext = tmp; }
    }
    if (mi == 1 && ntw == NT) pv_tile(lds + vprev + vfo, pw, o);
    float gsub[4];
#pragma unroll
    for (int d = 0; d < 4; ++d) gsub[d] = subg[d * 32 + r32] * oscale;
    if (qb_next >= 0) {
        LOADT(0);
        const bf16* qp = QO + (rowbase + qb_next * 128 + rb * 32 + r32) * DM + h * 128 + mi * 64 + hi * 8;
#pragma unroll
        for (int d0 = 0; d0 < 4; ++d0) qr[d0] = *(const bf16x8*)(qp + d0 * 16);
    }
#undef LOADT
#undef STORET
    if (!SAFE) { const bool wbad = __any(!(lsum < 1.0e30f)) FORCE_BAD_EXPR; if (lane == 0) wsf[63] = wbad ? 1.0f : 0.0f; }
    __syncthreads();
    bool bad = false;
    if (!SAFE) { float fl = 0.f;
#pragma unroll
        for (int i = 0; i < NWAVES; ++i) fl += ((LAS float*)(lds + OFF_WSF + i * 256))[63];
        bad = fl > 0.f; }
    { auto rr = __builtin_amdgcn_permlane32_swap(__float_as_uint(lsum), __float_as_uint(lsum), false, false); lsum = __uint_as_float(rr[0]) + __uint_as_float(rr[1]); }
    if (hi == 0) wsf[r32] = (mi ? -lam : 1.0f) / lsum;
    asm volatile("s_waitcnt lgkmcnt(0)" ::: "memory");
#pragma unroll
    for (int r = 0; r < 16; ++r) { const float fr_ = wsf[crow(r, hi)];
#pragma unroll
        for (int d = 0; d < 4; ++d) o[d][r] *= fr_; }
    LAS float* xch = (LAS float*)lds + rb * (4 * 16 * 64);
    if (mi == 1) {
#pragma unroll
        for (int d = 0; d < 4; ++d)
#pragma unroll
            for (int r = 0; r < 16; ++r) xch[(d * 16 + r) * 64 + lane] = o[d][r];
    }
    __syncthreads();
    if (mi == 0 && !dry && !bad) {
        bf16* op = QO + (rowbase + q0 + rb * 32) * DM + h * 128 + r32;
#pragma unroll
        for (int r = 0; r < 16; ++r) {
            float ss = 0.f;
#pragma unroll
            for (int d = 0; d < 4; ++d) { o[d][r] += xch[(d * 16 + r) * 64 + lane]; ss += o[d][r] * o[d][r]; }
            ss += __shfl_xor(ss, 1); ss += __shfl_xor(ss, 2); ss += __shfl_xor(ss, 4); ss += __shfl_xor(ss, 8); ss += __shfl_xor(ss, 16);
            const float rs = rsqrtf(ss * (1.0f / 128.0f) + 1e-6f);
#pragma unroll
            for (int d = 0; d < 4; ++d) op[(size_t)crow(r, hi) * DM + d * 32] = (bf16)f2bf(o[d][r] * rs * gsub[d]);
        }
    }
    __syncthreads();
    return bad;
}
constexpr int SG_STAT = 0, SG_V = 1024, SG_M = SG_V + 128 * VSTR, SG_END = SG_M + 128 * 132 * 4;
static_assert(SG_END <= 131072, "sgu LDS map");
__device__ __forceinline__ void sgu_unit(int n, int g, bf16* UO, const bf16* __restrict__ VBp, const float* __restrict__ VST, const bf16* __restrict__ Wm, const float* __restrict__ bs,
                                         const float* __restrict__ lng, const float* __restrict__ lnb, LAS unsigned char* lds) {
    int tid_ = threadIdx.x; asm volatile("" : "+v"(tid_));
    const int tid = tid_, lane = tid & 63, r32 = lane & 31, hi = lane >> 5; const int w = __builtin_amdgcn_readfirstlane(tid >> 6);
    const size_t row0 = (size_t)n * 128; const int ch = tid & 15, tb = w & 3, cb0 = (w >> 2) * 2;
    f32x4 st8[8];
    if (tid < 128) { const f32x4* sp = (const f32x4*)(VST + (row0 + tid) * 32);
#pragma unroll
        for (int i = 0; i < 8; ++i) st8[i] = sp[i]; }
    u32x4 vv[4], uu[4]; bf16* up_[4];
#pragma unroll
    for (int i = 0; i < 4; ++i) { const int row = (tid >> 4) + 32 * i; vv[i] = *(const u32x4*)(VBp + (row0 + row) * DM + g * 128 + ch * 8); up_[i] = UO + (row0 + row) * DM + g * 128 + ch * 8; uu[i] = *(const u32x4*)up_[i]; }
    const f32x4 gg0 = *(const f32x4*)(lng + g * 128 + ch * 8), gg1 = *(const f32x4*)(lng + g * 128 + ch * 8 + 4), bb0 = *(const f32x4*)(lnb + g * 128 + ch * 8), bb1 = *(const f32x4*)(lnb + g * 128 + ch * 8 + 4);
    const bf16* wp = Wm + (size_t)g * 128 * 128 + (size_t)(tb * 32 + r32) * 128 + hi * 8;
    bf16x8 af[8];
#pragma unroll
    for (int ks = 0; ks < 8; ++ks) af[ks] = *(const bf16x8*)(wp + ks * 16);
    f32x4 bs4[4];
#pragma unroll
    for (int k = 0; k < 4; ++k) bs4[k] = *(const f32x4*)(bs + g * 128 + tb * 32 + 8 * k + 4 * hi);
    LAS f32x2* stat = (LAS f32x2*)(lds + SG_STAT);
    if (tid < 128) { float s1 = 0.f, s2 = 0.f;
#pragma unroll
        for (int i = 0; i < 8; ++i) { s1 += st8[i][0] + st8[i][2]; s2 += st8[i][1] + st8[i][3]; }
        const float mu = s1 * (1.0f / 1024.0f), var = fmaxf(s2 * (1.0f / 1024.0f) - mu * mu, 0.f);
        stat[tid] = (f32x2){mu, rsqrtf(var + 1e-6f)}; }
    __syncthreads();
    { const float gg[8] = {gg0[0], gg0[1], gg0[2], gg0[3], gg1[0], gg1[1], gg1[2], gg1[3]}, bb[8] = {bb0[0], bb0[1], bb0[2], bb0[3], bb1[0], bb1[1], bb1[2], bb1[3]};
#pragma unroll
      for (int i = 0; i < 4; ++i) { const int row = (tid >> 4) + 32 * i; const u32x4 v = vv[i]; const f32x2 st = stat[row];
          float f[8] = {bflo(v.x), bfhi(v.x), bflo(v.y), bfhi(v.y), bflo(v.z), bfhi(v.z), bflo(v.w), bfhi(v.w)};
#pragma unroll
          for (int e = 0; e < 8; ++e) f[e] = (f[e] - st.x) * st.y * gg[e] + bb[e];
          u32x4 o; o.x = pk2(f[0], f[1]); o.y = pk2(f[2], f[3]); o.z = pk2(f[4], f[5]); o.w = pk2(f[6], f[7]);
          *(LAS u32x4*)(lds + SG_V + row * VSTR + ch * 16) = o; } }
    __syncthreads();
    f32x16 acc[2];
#pragma unroll
    for (int j = 0; j < 2; ++j)
#pragma unroll
        for (int r = 0; r < 16; ++r) acc[j][r] = 0.f;
    const LAS unsigned char* vb = lds + SG_V + (8 * hi + ((lane & 15) >> 2)) * VSTR + (((lane >> 4) & 1) * 16 + (lane & 3) * 4) * 2;
#pragma unroll
    for (int ks = 0; ks < 8; ++ks) {
        if (ks < 4 || tb >= 2) {
#pragma unroll
            for (int j = 0; j < 2; ++j) {
                const s16x4 lo = __builtin_bit_cast(s16x4, __builtin_amdgcn_ds_read_tr16_b64_v4i16((LAS s16x4*)(vb + ks * 16 * VSTR + (cb0 + j) * 64)));
                const s16x4 up = __builtin_bit_cast(s16x4, __builtin_amdgcn_ds_read_tr16_b64_v4i16((LAS s16x4*)(vb + ks * 16 * VSTR + 4 * VSTR + (cb0 + j) * 64)));
                const bf16x8 vf = (bf16x8){lo[0], lo[1], lo[2], lo[3], up[0], up[1], up[2], up[3]};
                acc[j] = __builtin_amdgcn_mfma_f32_32x32x16_bf16(af[ks], vf, acc[j], 0, 0, 0);
            }
        }
    }
    LAS float* M = (LAS float*)(lds + SG_M);
#pragma unroll
    for (int j = 0; j < 2; ++j)
#pragma unroll
        for (int r = 0; r < 16; ++r) { const int t = tb * 32 + crow(r, hi); M[t * 132 + (cb0 + j) * 32 + r32] = acc[j][r] + bs4[r >> 2][r & 3]; }
    __syncthreads();
#pragma unroll
    for (int i = 0; i < 4; ++i) { const int row = (tid >> 4) + 32 * i; const u32x4 v = uu[i];
        const f32x4 m0 = *(const LAS f32x4*)(M + row * 132 + ch * 8), m1 = *(const LAS f32x4*)(M + row * 132 + ch * 8 + 4);
        u32x4 o; o.x = pk2(bflo(v.x) * m0[0], bfhi(v.x) * m0[1]); o.y = pk2(bflo(v.y) * m0[2], bfhi(v.y) * m0[3]); o.z = pk2(bflo(v.z) * m1[0], bfhi(v.z) * m1[1]); o.w = pk2(bflo(v.w) * m1[2], bfhi(v.w) * m1[3]);
        *(u32x4*)up_[i] = o; }
    __syncthreads();
}
}
#define RLX_AGENT __ATOMIC_RELAXED, __HIP_MEMORY_SCOPE_AGENT
#define LDS_WAIT() asm volatile("s_waitcnt lgkmcnt(0)" ::: "memory")
#define VM_WAIT() asm volatile("s_waitcnt vmcnt(0)" ::: "memory")
#define XB_TMO      128
#define XB_XCNT(j)  (256  + 64 * (j))
#define XB_XSUB(j)  (1280 + 64 * (j))
#define XB_XGEN(j)  (2304 + 64 * (j))
#define XB_TOP      3328
#define XB_TOPGEN   3392
#define XCD_BAR_WORDS 3456
#define XB_SPIN_CAP (1u << 18)

__device__ __forceinline__ unsigned xb_ld(unsigned* p)              { return __hip_atomic_load(p, __ATOMIC_RELAXED, __HIP_MEMORY_SCOPE_AGENT); }
__device__ __forceinline__ unsigned xb_add(unsigned* p, unsigned v) { return __hip_atomic_fetch_add(p, v, __ATOMIC_RELAXED, __HIP_MEMORY_SCOPE_AGENT); }
__device__ __forceinline__ unsigned xb_xcc_id() { return (unsigned)__builtin_amdgcn_s_getreg((3 << 11) | 20) & 0xFu; }
#define XB_SPIN(cond, bar) do { unsigned _sp = 0; while (cond) { __builtin_amdgcn_s_sleep(1); \
    if ((++_sp & 255u) == 0u) { if (xb_ld(&(bar)[XB_TMO])) break; if (_sp > XB_SPIN_CAP) { atomicAdd(&(bar)[XB_TMO], 1u); break; } } } } while (0)

struct XcdBarrier {
    unsigned* bar; unsigned x;
    volatile LAS unsigned* st;
};

__device__ __forceinline__ XcdBarrier xcd_barrier_post(unsigned* bar, volatile LAS unsigned* st) {
    XcdBarrier b; b.bar = bar; b.x = xb_xcc_id(); b.st = st;
    if (threadIdx.x == 0) (void)xb_add(&bar[XB_XCNT(b.x)], 1u);
    return b;
}
__device__ __forceinline__ void xcd_barrier_complete(unsigned* bar, unsigned x, unsigned& nloc, unsigned& nx) {
    const unsigned G = gridDim.x * gridDim.y * gridDim.z;
    unsigned sum, cnt, mine, sp = 0u;
    for (;;) {
        sum = 0u; cnt = 0u; mine = 0u;
#pragma unroll
        for (unsigned j = 0; j < 16; ++j) { const unsigned c = xb_ld(&bar[XB_XCNT(j)]); sum += c; cnt += (c > 0u) ? 1u : 0u; mine = (j == x) ? c : mine; }
        if (sum == G) break;
        __builtin_amdgcn_s_sleep(1);
        if ((++sp & 255u) == 0u) { if (xb_ld(&bar[XB_TMO])) break; if (sp > XB_SPIN_CAP) { atomicAdd(&bar[XB_TMO], 1u); break; } }
    }
    nloc = mine > 0u ? mine : 1u; nx = cnt > 0u ? cnt : 1u;
}

__device__ __forceinline__ void xcd_barrier(const XcdBarrier& b) {
    asm volatile("s_waitcnt vmcnt(0)" ::: "memory");
    __syncthreads();
    if (threadIdx.x == 0) {
        unsigned* bar = b.bar;
        __builtin_amdgcn_s_waitcnt(0);
        unsigned nloc = b.st[0], nx = b.st[1];
        if (nloc == 0u) { xcd_barrier_complete(bar, b.x, nloc, nx); b.st[0] = nloc; b.st[1] = nx; }
        const unsigned old = xb_add(&bar[XB_XSUB(b.x)], 1u);
        const unsigned gen = old / nloc;
        if (old + 1u == (gen + 1u) * nloc) {
            __builtin_amdgcn_fence(__ATOMIC_RELEASE, "agent");
            asm volatile("s_waitcnt vmcnt(0)" ::: "memory");
            const unsigned og = xb_add(&bar[XB_TOP], 1u);
            const unsigned tg = og / nx;
            if (og + 1u == (tg + 1u) * nx) xb_add(&bar[XB_TOPGEN], 1u);
            else XB_SPIN(xb_ld(&bar[XB_TOPGEN]) == tg, bar);
            __builtin_amdgcn_fence(__ATOMIC_ACQUIRE, "agent");
            xb_add(&bar[XB_XGEN(b.x)], 1u);
            asm volatile("s_waitcnt vmcnt(0)" ::: "memory");
        } else {
            XB_SPIN(xb_ld(&bar[XB_XGEN(b.x)]) == gen, bar);
            __builtin_amdgcn_fence(__ATOMIC_ACQUIRE, "agent");
            asm volatile("s_waitcnt vmcnt(0)" ::: "memory");
        }
    }
    __syncthreads();
}

constexpr int LDS_RTAB = 131072;
template <int NU>
__device__ __forceinline__ void rstd_table(const pg8::StaticOrder& S, const float* SS, LAS unsigned char* lds, int tid) {
    static_assert(NU * 256 * 4 <= 147392 - LDS_RTAB, "rstd table fits above the ring");
    f32x4 a[NU][2]; const int row = tid >> 1, half = tid & 1;
#pragma unroll
    for (int i = 0; i < NU; ++i) { pg8::Unit u; if (S.next(i, u)) { const f32x4* sp = (const f32x4*)(SS + ((size_t)u.pm * 256 + row) * 16 + 8 * half); a[i][0] = sp[0]; a[i][1] = sp[1]; } else { a[i][0] = (f32x4){1.f, 0.f, 0.f, 0.f}; a[i][1] = (f32x4){0.f, 0.f, 0.f, 0.f}; } }
#pragma unroll
    for (int i = 0; i < NU; ++i) { float s = ((a[i][0][0] + a[i][0][1]) + (a[i][0][2] + a[i][0][3])) + ((a[i][1][0] + a[i][1][1]) + (a[i][1][2] + a[i][1][3]));
        s += __shfl_xor(s, 1);
        if (half == 0) ((LAS float*)(lds + LDS_RTAB))[i * 256 + row] = rsqrtf(s * (1.0f / 1024.0f) + 1e-6f); }
    __syncthreads();
}
constexpr int NPH = 2 + 6 * DEPTH;
#ifndef ONE_LAUNCH
#define ONE_LAUNCH 1
#endif
__global__ void __launch_bounds__(NTHR, 2) fwd_megakernel(Params p_unused) {
    extern __shared__ __attribute__((aligned(16))) unsigned char lds_raw[];
    LAS unsigned char* lds = (LAS unsigned char*)lds_raw;
    int ph_lo, ph_hi;
    { PP p = (PP)__builtin_amdgcn_kernarg_segment_ptr(); ph_lo = p->ph_lo; ph_hi = p->ph_hi; }
#if ONE_LAUNCH
    if (threadIdx.x < 16) ((LAS unsigned*)(lds + LDS_XB))[threadIdx.x] = 0u;
    __syncthreads();
    { PP p = (PP)__builtin_amdgcn_kernarg_segment_ptr(); (void)xcd_barrier_post((unsigned*)(p->ws + WS_CTL), (volatile LAS unsigned*)(lds + LDS_XB)); }
#endif
    for (int ph = ph_lo; ph < ph_hi; ++ph) {
        PP p = (PP)__builtin_amdgcn_kernarg_segment_ptr(); asm volatile("" : "+s"(p));
        int tid_ = threadIdx.x; asm volatile("" : "+v"(tid_));
        const int tid = tid_, lane = tid & 63, wave = __builtin_amdgcn_readfirstlane(tid >> 6);
        const int G = gridDim.x, bx = blockIdx.x, vcu = (G % 8 == 0) ? (bx % 8) * (G / 8) + bx / 8 : bx;
        const int gw = vcu * NWAVES + wave, NGW = G * NWAVES;
        unsigned char* ws = p->ws;
        if (ph == 0) {
            prologue(p, lds, gw, NGW, wave, lane);
        } else if (ph == NPH - 1) {
            final_norm(p, gw, NGW, lane);
        } else {
            const int l = (ph - 1) / 6, k = (ph - 1) % 6;
            if (k == 0) {
                pg8::Gemm g{(const bf16*)(ws + WS_XB), (const bf16*)(ws + WS_WIN), T, NIN, DM}; pg8::StaticOrder S; S.init(T, NIN, G, bx);
                rstd_table<14>(S, (const float*)(ws + WS_SS), lds, tid);
                pg8::EpiIn E{(const float*)(ws + WS_SS), (const float*)(ws + WS_COS), (const float*)(ws + WS_SIN), (bf16*)(ws + WS_Q), (bf16*)(ws + WS_K), (bf16*)(ws + WS_VA), (bf16*)(ws + WS_U), (bf16*)(ws + WS_VB), ws + WS_GA, ws + WS_GB, (float*)(ws + WS_VST), (const LAS float*)(lds + LDS_RTAB), 14};
                pg8::gemm_phase<pg8::EpiIn, pg8::StaticOrder, true, true>(lds, g, S, E);
            } else if (k == 1) {
                if (l > 0) { convert_B(p, l, lds, gw, NGW, wave, lane); __syncthreads(); }
                float sa = p->in[3][l * 64 + lane] * p->in[4][l * 64 + lane], sb = p->in[5][l * 64 + lane] * p->in[6][l * 64 + lane];
                sa = wave_sum(sa); sb = wave_sum(sb);
                const float lam_init = 0.8f - 0.6f * __expf(-0.3f * (float)l);
                const float lam = __expf(sa) - __expf(sb) + lam_init;
                for (int v = vcu; v < 256; v += G) {
                    for (int gi = 0; gi < 8; ++gi)
                        att::sgu_unit(v, gi, (bf16*)(ws + WS_U), (const bf16*)(ws + WS_VB), (const float*)(ws + WS_VST), (const bf16*)(ws + WS_WSP) + (size_t)l * 8 * 128 * 128, p->in[11] + (size_t)l * 8 * 128, p->in[8] + (size_t)l * DM, p->in[9] + (size_t)l * DM, lds);
                    const int bh = v >> 2, j = v & 3;
                    u32x4 sk0, sk1, sv0, sv1; bf16x8 qr[4]; unsigned badmask = 0u;
                    {
                        const int w_ = wave, mi_ = w_ >> 2, rb_ = w_ & 3, r32_ = lane & 31, hi_ = lane >> 5, skey = tid >> 4, sch = tid & 15; const size_t rowbase = (size_t)(bh >> 3) * SEQ; const int h_ = bh & 7;
                        const bf16* kgp = (const bf16*)(ws + WS_K) + (rowbase + skey) * DM + h_ * 128 + sch * 8; const bf16* vgp = (const bf16*)(ws + WS_VA) + (rowbase + skey) * DM + h_ * 128 + sch * 8;
                        sk0 = *(const u32x4*)kgp; sk1 = *(const u32x4*)(kgp + 32 * DM); sv0 = *(const u32x4*)vgp; sv1 = *(const u32x4*)(vgp + 32 * DM);
                        const bf16* qp = (const bf16*)(ws + WS_Q) + (rowbase + j * 128 + rb_ * 32 + r32_) * DM + h_ * 128 + mi_ * 64 + hi_ * 8;
#pragma unroll
                        for (int d0 = 0; d0 < 4; ++d0) qr[d0] = *(const bf16x8*)(qp + d0 * 16); }
                    for (int i = 0; i < 8; ++i) { const int s = j + 4 * (i >> 1), qb = (i & 1) ? 31 - s : s; const int s2 = j + 4 * ((i + 1) >> 1), qbn = i + 1 < 8 ? (((i + 1) & 1) ? 31 - s2 : s2) : -1;
                        if (att::attn_unit<false>(bh >> 3, bh & 7, qb, qbn, sk0, sk1, sv0, sv1, qr, (bf16*)(ws + WS_Q), (const bf16*)(ws + WS_K), (const bf16*)(ws + WS_VA), lam, 1.0f - lam_init, p->in[7] + (size_t)l * 128, lds)) badmask |= 1u << i; }
                    for (int i = 0; i < 8; ++i) if ((badmask >> i) & 1u) { const int s = j + 4 * (i >> 1), qb = (i & 1) ? 31 - s : s;
                        (void)att::attn_unit<true>(bh >> 3, bh & 7, qb, -1, sk0, sk1, sv0, sv1, qr, (bf16*)(ws + WS_Q), (const bf16*)(ws + WS_K), (const bf16*)(ws + WS_VA), lam, 1.0f - lam_init, p->in[7] + (size_t)l * 128, lds); }
                }
            } else if (k == 2) {
                pg8::Gemm g{(const bf16*)(ws + WS_Q), (const bf16*)(ws + WS_WPAB), 2 * T, 2 * DM, DM}; pg8::ProjOrder S; S.init(T, DM, G, bx);
                pg8::EpiProj E{ws + WS_GA, ws + WS_GB, (bf16*)(ws + WS_Y)};
                pg8::gemm_phase<pg8::EpiProj, pg8::ProjOrder, true, true>(lds, g, S, E);
            } else if (k == 3 || k == 5) {
                pg8::Gemm g{(const bf16*)(ws + (k == 3 ? WS_Y : WS_H)), (const bf16*)(ws + (k == 3 ? WS_WOUT : WS_WD)), T, DM, k == 3 ? DM : DFF}; pg8::StaticOrder S; S.init(T, DM, G, bx);
                pg8::EpiRes E{(bf16*)(ws + WS_XB), (float*)(ws + WS_SS)};
                pg8::gemm_phase<pg8::EpiRes, pg8::StaticOrder, true, true>(lds, g, S, E);
            } else {
                if (l + 1 < DEPTH) { convert_A(p, l + 1, lds, gw, NGW, wave, lane); __syncthreads(); }
                pg8::Gemm g{(const bf16*)(ws + WS_XB), (const bf16*)(ws + WS_WGU), T, NGU, DM}; pg8::StaticOrder S; S.init(T, NGU, G, bx);
                rstd_table<11>(S, (const float*)(ws + WS_SS), lds, tid);
                pg8::EpiGU E{(const float*)(ws + WS_SS), (bf16*)(ws + WS_H), (const LAS float*)(lds + LDS_RTAB), 11};
                pg8::gemm_phase<pg8::EpiGU, pg8::StaticOrder, true, true>(lds, g, S, E);
            }
        }
        if (ph + 1 < ph_hi) {
            if (ph_hi > 4096) cg::this_grid().sync();
            else { XcdBarrier xb; xb.bar = (unsigned*)(p->ws + WS_CTL); xb.x = xb_xcc_id(); xb.st = (volatile LAS unsigned*)(lds + LDS_XB); xcd_barrier(xb); }
        }
    }
}

extern "C" void kernel_launch(void* const* d_in, const int* in_sizes, int n_in, void* d_out, int out_size, void* d_ws, size_t ws_size, hipStream_t stream) {
    static int grid = 0;
    if (grid == 0) {
        if (n_in != 20 || in_sizes[0] != T * DM || out_size != T * DM || ws_size < WS_END) { fprintf(stderr, "kernel_launch: unexpected shapes / workspace (n_in %d, ws %zu)\n", n_in, ws_size); grid = -1; return; }
        int dev = 0, cus = 0, per_cu = 0;
        if (hipGetDevice(&dev) != hipSuccess || hipDeviceGetAttribute(&cus, hipDeviceAttributeMultiprocessorCount, dev) != hipSuccess) { grid = -1; return; }
        if (hipFuncSetAttribute((const void*)fwd_megakernel, hipFuncAttributeMaxDynamicSharedMemorySize, LDS_BYTES) != hipSuccess) { fprintf(stderr, "kernel_launch: hipFuncSetAttribute failed\n"); grid = -1; return; }
        if (hipOccupancyMaxActiveBlocksPerMultiprocessor(&per_cu, (const void*)fwd_megakernel, NTHR, LDS_BYTES) != hipSuccess || per_cu < 1) per_cu = 1;
        (void)hipGetLastError();
        grid = cus * per_cu;
    }
    if (grid < 0) return;
    Params p{};
    for (int i = 0; i < 20; ++i) p.in[i] = (const float*)d_in[i];
    p.out = (float*)d_out; p.ws = (unsigned char*)d_ws;
#if ONE_LAUNCH
    (void)hipMemsetAsync((char*)d_ws + WS_CTL, 0, CTL_ZERO_BYTES, stream);
    p.ph_lo = 0; p.ph_hi = NPH;
    void* args[] = {&p};
    hipError_t e = hipLaunchCooperativeKernel((const void*)fwd_megakernel, dim3(grid), dim3(NTHR), args, LDS_BYTES, stream);
    if (e != hipSuccess) fprintf(stderr, "cooperative launch failed: %s (grid %d)\n", hipGetErrorString(e), grid);
#else
    for (int ph = 0; ph < NPH; ++ph) { p.ph_lo = ph; p.ph_hi = ph + 1; hipLaunchKernelGGL(fwd_megakernel, dim3(grid), dim3(NTHR), LDS_BYTES, stream, p); }
#endif
}
```
